# Optimizing an MI355X kernel written in HIP

```python
import jax, jax.numpy as jnp
from jax import lax
import numpy as np

D_MODEL = 1024
BATCH = 8
SEQ = 8192
DEPTH = 1
DEC_BATCH = 16
DEC_SEQ = 2048
PAST_LEN = 128

DN_HEADS = 4
DN_DK = 128
DN_DV = 128
DN_QK = DN_HEADS * DN_DK
DN_V = DN_HEADS * DN_DV
DN_CHUNK = 64
CONV_K = 5
DN_CONV_CH = 2 * DN_QK + DN_V
SG_GROUPS = 4
SG_GROUP_DIM = 128
SG_WIDTH = SG_GROUPS * SG_GROUP_DIM
SG_CHUNK = 128
N_MEM = 256
XA_HEADS = 4
XA_HEAD_DIM = D_MODEL // XA_HEADS
D_FF = ((8 * D_MODEL + 3 * 256 - 1) // (3 * 256)) * 256
N_IN = DN_CONV_CH + 4 * DN_HEADS + DN_V + 2 * SG_WIDTH + 2 * D_MODEL
EPS = 1e-6

kernel_name = 'hybrid_deltanet_gmlp_memxattn_encoder'


def rmsnorm(x, w):
    xf = x.astype(jnp.float32)
    y = xf * lax.rsqrt(jnp.mean(xf * xf, -1, keepdims=True) + EPS)
    return (y * w.astype(jnp.float32)).astype(x.dtype)


def layernorm(x, w, b):
    xf = x.astype(jnp.float32)
    mu = jnp.mean(xf, -1, keepdims=True)
    xc = xf - mu
    y = xc * lax.rsqrt(jnp.mean(xc * xc, -1, keepdims=True) + EPS)
    return (y * w.astype(jnp.float32) + b.astype(jnp.float32)).astype(x.dtype)


def l2norm(x):
    xf = x.astype(jnp.float32)
    return (xf * lax.rsqrt(jnp.sum(xf * xf, -1, keepdims=True) + EPS)).astype(x.dtype)


def depthwise_conv(x, w):
    c = x.shape[-1]
    return lax.conv_general_dilated(
        x, w[:, None, :].astype(x.dtype), window_strides=(1,),
        padding=[(CONV_K // 2, CONV_K // 2)],
        dimension_numbers=('NWC', 'WIO', 'NWC'), feature_group_count=c)


def gated_delta_chunked(q, k, v, g, beta):
    out_dtype = v.dtype
    bsz, nh, seq, dk = q.shape
    dv = v.shape[-1]
    c = DN_CHUNK
    n = seq // c
    q = q.astype(jnp.float32).reshape(bsz, nh, n, c, dk) * (dk ** -0.5)
    k = k.astype(jnp.float32).reshape(bsz, nh, n, c, dk)
    v = v.astype(jnp.float32).reshape(bsz, nh, n, c, dv)
    g = jnp.cumsum(g.astype(jnp.float32).reshape(bsz, nh, n, c), -1)
    beta = beta.astype(jnp.float32).reshape(bsz, nh, n, c)
    incl = jnp.tril(jnp.ones((c, c), dtype=bool))
    strict = jnp.tril(jnp.ones((c, c), dtype=bool), -1)
    diff = g[..., :, None] - g[..., None, :]
    decay = jnp.where(incl, jnp.exp(jnp.where(incl, diff, 0.0)), 0.0)
    kb = k * beta[..., None]
    lower = jnp.where(strict, jnp.einsum('bhncd,bhnsd->bhncs', kb, k) * decay, 0.0)
    eye = jnp.eye(c, dtype=jnp.float32)
    tinv = lax.linalg.triangular_solve(lower + eye, jnp.broadcast_to(eye, lower.shape),
                                       left_side=True, lower=True, unit_diagonal=True)
    u = jnp.einsum('bhncs,bhnsd->bhncd', tinv, v * beta[..., None])
    w = jnp.einsum('bhncs,bhnsd->bhncd', tinv, kb * jnp.exp(g)[..., None])
    a_intra = jnp.einsum('bhncd,bhnsd->bhncs', q, k) * decay
    g_last = g[..., -1]
    qg = q * jnp.exp(g)[..., None]
    kg = k * jnp.exp(g_last[..., None] - g)[..., None]

    def step(state, xs):
        qg_i, kg_i, u_i, w_i, a_i, gl_i = xs
        v_new = u_i - jnp.einsum('bhcd,bhde->bhce', w_i, state)
        o = jnp.einsum('bhcd,bhde->bhce', qg_i, state) + jnp.einsum('bhcs,bhse->bhce', a_i, v_new)
        state = state * jnp.exp(gl_i)[..., None, None] + jnp.einsum('bhcd,bhce->bhde', kg_i, v_new)
        return state, o

    xs = tuple(jnp.moveaxis(t, 2, 0) for t in (qg, kg, u, w, a_intra, g_last))
    s0 = jnp.zeros((bsz, nh, dk, dv), jnp.float32)
    _, o = lax.scan(step, s0, xs)
    o = jnp.moveaxis(o, 0, 2).reshape(bsz, nh, seq, dv)
    return o.astype(out_dtype)


def deltanet_branch(qkv_raw, ab, gate, conv_w, a_log, dt_bias, norm_w):
    bsz, seq, _ = qkv_raw.shape
    qkv = jax.nn.silu(depthwise_conv(qkv_raw, conv_w))
    q = qkv[..., :DN_QK]
    k = qkv[..., DN_QK:2 * DN_QK]
    v = qkv[..., 2 * DN_QK:]
    heads = lambda t, d: jnp.transpose(t.reshape(bsz, seq, DN_HEADS, d), (0, 2, 1, 3))
    q = l2norm(heads(q, DN_DK))
    k = l2norm(heads(k, DN_DK))
    v = heads(v, DN_DV)
    ab = jnp.transpose(ab.astype(jnp.float32).reshape(bsz, seq, 4, DN_HEADS), (2, 0, 3, 1))
    beta_f = jax.nn.sigmoid(ab[0])
    beta_b = jax.nn.sigmoid(ab[1])
    a_log = a_log.astype(jnp.float32)
    dt_bias = dt_bias.astype(jnp.float32)
    g_f = -jnp.exp(a_log[0])[None, :, None] * jax.nn.softplus(ab[2] + dt_bias[0][None, :, None])
    g_b = -jnp.exp(a_log[1])[None, :, None] * jax.nn.softplus(ab[3] + dt_bias[1][None, :, None])
    o_f = gated_delta_chunked(q, k, v, g_f, beta_f)
    flip = lambda t: jnp.flip(t, axis=2)
    o_b = flip(gated_delta_chunked(flip(q), flip(k), flip(v), flip(g_b), flip(beta_b)))
    o = jnp.transpose(o_f + o_b, (0, 2, 1, 3))
    o = rmsnorm(o, norm_w) * jax.nn.silu(gate.reshape(bsz, seq, DN_HEADS, DN_DV))
    return o.reshape(bsz, seq, DN_V)


def spatial_gating_branch(u, v, ln_w, ln_b, w_s, b_s):
    bsz, seq, _ = u.shape
    u = jax.nn.gelu(u)
    v = layernorm(jax.nn.gelu(v), ln_w, ln_b)
    v = v.reshape(bsz, seq // SG_CHUNK, SG_CHUNK, SG_GROUPS, SG_GROUP_DIM)
    mixed = jnp.einsum('gts,bnsgc->bntgc', w_s, v) + jnp.transpose(b_s)[None, None, :, :, None]
    return u * mixed.reshape(bsz, seq, SG_WIDTH)


def memory_cross_attention(h, mem, w_q, w_kv, w_o):
    bsz, seq, _ = h.shape
    q = (h @ w_q).reshape(bsz, seq, XA_HEADS, XA_HEAD_DIM)
    kv = (mem @ w_kv).reshape(bsz, mem.shape[1], 2, XA_HEADS, XA_HEAD_DIM)
    k = kv[:, :, 0]
    v = kv[:, :, 1]
    s = jnp.einsum('blhd,bmhd->bhlm', q, k).astype(jnp.float32) * (XA_HEAD_DIM ** -0.5)
    p = jax.nn.softmax(s, axis=-1).astype(v.dtype)
    o = jnp.einsum('bhlm,bmhd->blhd', p, v).reshape(bsz, seq, D_MODEL)
    return o @ w_o


def encoder_layer(x, mem, norm_mix_w, w_in, conv_w, dn_a_log, dn_dt_bias, dn_norm_w, w_up_a,
                  sg_ln_w, sg_ln_b, sg_w, sg_b, w_up_b, w_out, norm_xa_w, norm_mem_w,
                  xa_w_q, xa_w_kv, xa_w_o, norm_ffn_w, ffn_w_gate_up, ffn_w_down):
    h = rmsnorm(x, norm_mix_w)
    proj = h @ w_in
    sizes = [DN_CONV_CH, 4 * DN_HEADS, DN_V, SG_WIDTH, SG_WIDTH, D_MODEL]
    qkv_raw, ab, dn_gate, sg_u, sg_v, gate_a, gate_b = jnp.split(proj, np.cumsum(sizes).tolist(), axis=-1)
    y_a = deltanet_branch(qkv_raw, ab, dn_gate, conv_w, dn_a_log, dn_dt_bias, dn_norm_w) @ w_up_a
    y_b = spatial_gating_branch(sg_u, sg_v, sg_ln_w, sg_ln_b, sg_w, sg_b) @ w_up_b
    merged = jax.nn.sigmoid(gate_a) * y_a + jax.nn.sigmoid(gate_b) * y_b
    x = x + merged @ w_out
    x = x + memory_cross_attention(rmsnorm(x, norm_xa_w), rmsnorm(mem, norm_mem_w), xa_w_q, xa_w_kv, xa_w_o)
    h = rmsnorm(x, norm_ffn_w)
    gu = h @ ffn_w_gate_up
    x = x + (jax.nn.silu(gu[..., :D_FF]) * gu[..., D_FF:]) @ ffn_w_down
    return x


def setup_inputs(seed: int = 0) -> dict:
    key = jax.random.key(seed)
    ks = iter(jax.random.split(key, 48))
    f32 = jnp.float32
    nrm = lambda shape, fan: jax.random.normal(next(ks), shape, f32) * (fan ** -0.5)
    gain = lambda shape: 1.0 + 0.02 * jax.random.normal(next(ks), shape, f32)
    small = lambda shape: 0.02 * jax.random.normal(next(ks), shape, f32)
    nl = DEPTH
    a_log = jnp.log(jax.random.uniform(next(ks), (nl, 2, DN_HEADS), f32, 1.0, 16.0))
    dt = jnp.exp(jax.random.uniform(next(ks), (nl, 2, DN_HEADS), f32, np.log(1e-3), np.log(1e-1)))
    dt_bias = dt + jnp.log(-jnp.expm1(-dt))
    return {
        'x_prompt': jax.random.normal(next(ks), (BATCH, SEQ, D_MODEL), f32),
        'x_sample': jax.random.normal(next(ks), (DEC_BATCH, DEC_SEQ, D_MODEL), f32),
        'mem_prompt': jax.random.normal(next(ks), (BATCH, N_MEM, D_MODEL), f32),
        'mem_sample': jax.random.normal(next(ks), (DEC_BATCH, N_MEM, D_MODEL), f32),
        'norm_mix_w': gain((nl, D_MODEL)),
        'w_in': nrm((nl, D_MODEL, N_IN), D_MODEL),
        'conv_w': nrm((nl, CONV_K, DN_CONV_CH), CONV_K),
        'dn_a_log': a_log,
        'dn_dt_bias': dt_bias,
        'dn_norm_w': gain((nl, DN_DV)),
        'w_up_a': nrm((nl, DN_V, D_MODEL), DN_V),
        'sg_ln_w': gain((nl, SG_WIDTH)),
        'sg_ln_b': small((nl, SG_WIDTH)),
        'sg_w': nrm((nl, SG_GROUPS, SG_CHUNK, SG_CHUNK), SG_CHUNK),
        'sg_b': small((nl, SG_GROUPS, SG_CHUNK)),
        'w_up_b': nrm((nl, SG_WIDTH, D_MODEL), SG_WIDTH),
        'w_out': nrm((nl, D_MODEL, D_MODEL), D_MODEL),
        'norm_xa_w': gain((nl, D_MODEL)),
        'norm_mem_w': gain((nl, D_MODEL)),
        'xa_w_q': nrm((nl, D_MODEL, D_MODEL), D_MODEL),
        'xa_w_kv': nrm((nl, D_MODEL, 2 * D_MODEL), D_MODEL),
        'xa_w_o': nrm((nl, D_MODEL, D_MODEL), D_MODEL),
        'norm_ffn_w': gain((nl, D_MODEL)),
        'ffn_w_gate_up': nrm((nl, D_MODEL, 2 * D_FF), D_MODEL),
        'ffn_w_down': nrm((nl, D_FF, D_MODEL), D_FF),
        'final_norm_w': gain((D_MODEL,)),
    }


def reference(x_prompt, x_sample, mem_prompt, mem_sample, norm_mix_w, w_in, conv_w, dn_a_log,
              dn_dt_bias, dn_norm_w, w_up_a, sg_ln_w, sg_ln_b, sg_w, sg_b, w_up_b, w_out,
              norm_xa_w, norm_mem_w, xa_w_q, xa_w_kv, xa_w_o, norm_ffn_w, ffn_w_gate_up,
              ffn_w_down, final_norm_w):
    def trunk(x, mem):
        for l in range(DEPTH):
            x = encoder_layer(x, mem, norm_mix_w[l], w_in[l], conv_w[l], dn_a_log[l], dn_dt_bias[l],
                              dn_norm_w[l], w_up_a[l], sg_ln_w[l], sg_ln_b[l], sg_w[l], sg_b[l],
                              w_up_b[l], w_out[l], norm_xa_w[l], norm_mem_w[l], xa_w_q[l],
                              xa_w_kv[l], xa_w_o[l], norm_ffn_w[l], ffn_w_gate_up[l], ffn_w_down[l])
        return rmsnorm(x, final_norm_w)

    y_prompt = trunk(x_prompt, mem_prompt)
    y_sample = trunk(x_sample, mem_sample)
    return (y_prompt, y_sample)
```

```cpp
#include <hip/hip_runtime.h>
#include <hip/hip_cooperative_groups.h>
#include <cstdio>
namespace cg = cooperative_groups;

typedef unsigned short bf16_t;
typedef __attribute__((ext_vector_type(8))) short bf16x8;
typedef __attribute__((ext_vector_type(4))) float f32x4;
#define DI __device__ __forceinline__
#define MFMA(a, b, c) __builtin_amdgcn_mfma_f32_16x16x32_bf16((a), (b), (c), 0, 0, 0)

constexpr int NTOK = 98304, NPT = 65536, TS = 32768;
constexpr int HALF_LDS = 76032;
constexpr int LDS_BYTES = 2 * HALF_LDS;

constexpr size_t O_BAR = 0;
constexpr size_t O_WIN = 16384;
constexpr size_t O_WUPA = O_WIN + 5376ull * 1024 * 2;
constexpr size_t O_WUPB = O_WUPA + 1024ull * 512 * 2;
constexpr size_t O_WOUT = O_WUPB + 1024ull * 512 * 2;
constexpr size_t O_WQ = O_WOUT + 1024ull * 1024 * 2;
constexpr size_t O_WKV = O_WQ + 1024ull * 1024 * 2;
constexpr size_t O_WO = O_WKV + 2048ull * 1024 * 2;
constexpr size_t O_WGU = O_WO + 1024ull * 1024 * 2;
constexpr size_t O_WDN = O_WGU + 5632ull * 1024 * 2;
constexpr size_t O_SGW = O_WDN + 1024ull * 2816 * 2;
constexpr size_t O_MEMN = O_SGW + 4ull * 128 * 128 * 2;
constexpr size_t O_KB = O_MEMN + 6144ull * 1024 * 2;
constexpr size_t O_VT = O_KB + 6144ull * 1024 * 2;
constexpr size_t O_HB = O_VT + 6144ull * 1024 * 2;
constexpr size_t O_S = O_HB + 98304ull * 1024 * 2;
constexpr size_t O_PROJ = O_S;
constexpr size_t O_AB = O_PROJ + 32768ull * 5120 * 2;
constexpr size_t O_QKV = O_AB + 32768ull * 16 * 4;
constexpr size_t O_LNST = O_QKV + 32768ull * 1536 * 2;
constexpr size_t O_WB = O_LNST + 32768ull * 2 * 4;
constexpr size_t O_UB = O_WB + 2ull * 32768 * 512 * 2;
constexpr size_t O_AI = O_UB + 2ull * 32768 * 512 * 2;
constexpr size_t O_GC = O_AI + 2ull * 32768 * 4 * 64 * 2;
constexpr size_t O_OB = O_GC + 2ull * 32768 * 4 * 4;
constexpr size_t O_MERGED = O_QKV;
constexpr size_t O_DNO = O_AI;
constexpr size_t O_QX = O_S;
constexpr size_t O_ATT = O_S + 98304ull * 1024 * 2;
constexpr size_t O_ACT = O_S;

struct Params {
  const float *x_prompt, *x_sample, *mem_prompt, *mem_sample, *norm_mix_w, *w_in, *conv_w, *a_log, *dt_bias,
      *dn_norm_w, *w_up_a, *sg_ln_w, *sg_ln_b, *sg_w, *sg_b, *w_up_b, *w_out, *norm_xa_w, *norm_mem_w, *xa_w_q,
      *xa_w_kv, *xa_w_o, *norm_ffn_w, *ffn_w_gu, *ffn_w_down, *final_norm_w;
  float* out;
  char* ws;
};

typedef __bf16 hbf16x2 __attribute__((ext_vector_type(2)));
typedef float hf32x2 __attribute__((ext_vector_type(2)));
DI unsigned pack2(float a, float b) { const hf32x2 v = {a, b}; const hbf16x2 h = __builtin_convertvector(v, hbf16x2); return __builtin_bit_cast(unsigned, h); }
DI bf16_t f2bf(float x) { return (bf16_t)(pack2(x, x) & 0xffffu); }
DI float bf2f(bf16_t h) { return __uint_as_float(((unsigned)h) << 16); }
DI float lo2f(unsigned u) { return __uint_as_float(u << 16); }
DI float hi2f(unsigned u) { return __uint_as_float(u & 0xffff0000u); }
DI uint2 pack4(f32x4 v) { return make_uint2(pack2(v[0], v[1]), pack2(v[2], v[3])); }
DI float sigmoidf_(float x) { return __builtin_amdgcn_rcpf(1.f + __expf(-x)); }
DI float siluf_(float x) { return x * sigmoidf_(x); }
DI float geluf_(float x) { float z = 0.7978845608f * (x + 0.044715f * x * x * x); return x * sigmoidf_(2.f * z); }
template <int CTRL> DI float dpp_rot(float v) {
  return __builtin_bit_cast(float, __builtin_amdgcn_mov_dpp(__builtin_bit_cast(int, v), CTRL, 0xF, 0xF, true));
}
DI float sum16(float v) {
  v += dpp_rot<0x128>(v);
  v += dpp_rot<0x124>(v);
  v += dpp_rot<0x122>(v);
  v += dpp_rot<0x121>(v);
  return v;
}
DI float max16(float v) {
  v = fmaxf(v, dpp_rot<0x128>(v));
  v = fmaxf(v, dpp_rot<0x124>(v));
  v = fmaxf(v, dpp_rot<0x122>(v));
  v = fmaxf(v, dpp_rot<0x121>(v));
  return v;
}
DI float wave_sum(float v) {
  v = sum16(v);
  v += __shfl_xor(v, 16);
  v += __shfl_xor(v, 32);
  return v;
}
DI const float* xrow(const Params& p, int t) {
  return t < NPT ? p.x_prompt + (size_t)t * 1024 : p.x_sample + (size_t)(t - NPT) * 1024;
}


DI int VB() { return blockIdx.x * 2 + __builtin_amdgcn_readfirstlane(threadIdx.x >> 8); }
DI int VGRID() { return gridDim.x * 2; }
DI int opaque_tid() { int t = threadIdx.x; asm volatile("" : "+v"(t)); return t; }
DI void lds_barrier() { asm volatile("s_waitcnt lgkmcnt(0)" ::: "memory"); __builtin_amdgcn_s_barrier(); asm volatile("" ::: "memory"); }
typedef __attribute__((address_space(1))) char gchar_t;
DI char* opaque_ptr(char* q) { gchar_t* g = (gchar_t*)q; asm volatile("" : "+s"(g)); return (char*)g; }
DI void zero_acc(f32x4 (&acc)[4][4]) {
#pragma unroll
  for (int i = 0; i < 4; i++)
#pragma unroll
    for (int j = 0; j < 4; j++) acc[i][j] = f32x4{0.f, 0.f, 0.f, 0.f};
}

#define LAS __attribute__((address_space(3)))
namespace pg8 {
constexpr int BM = 256, BK = 64, HALF = 128, HTB = HALF * BK * 2, NXCD = 8, WGM = 8;
DI int lds_byte(int r, int c) { const int st = (r >> 4) * 2 + (c >> 5), rr = r & 15, cc = c & 31, ob = rr * 64 + cc * 2; return st * 1024 + (ob ^ (((ob >> 9) & 1) << 5)); }
DI int perm32(int rho) { const int n = rho >> 4, i = rho & 15; return 8 * (i >> 2) + 4 * n + (i & 3); }
DI void stage_rc(int b, int& R, int& C) { const int st = b / 1024, sb = b % 1024, swz = sb ^ (((sb >> 9) & 1) << 5); R = (st >> 1) * 16 + swz / 64; C = (st & 1) * 32 + (swz % 64) / 2; }
struct Unit { int pm, pn; };
struct Gemm { const bf16_t* A; const bf16_t* Bt; int M, N, K, lda, ldb; };
struct StaticOrder {
  int nM, nN, nwg, G, c;
  DI void init(int M, int N, int G_, int c_) { nM = M / BM; nN = N / BM; nwg = nM * nN; G = G_; c = c_; }
  DI bool next(int i, Unit& u) const {
    const long L = (long)i * G + c; if (L >= nwg) return false;
    int wgid = (int)L; { const int q = nwg / NXCD, r = nwg % NXCD, xcd = wgid % NXCD, off = wgid / NXCD; wgid = (xcd < r ? xcd * (q + 1) : r * (q + 1) + (xcd - r) * q) + off; }
    const int nig = WGM * nN, gid = wgid / nig, fm = gid * WGM, gsz = (nM - fm) < WGM ? (nM - fm) : WGM;
    u.pm = fm + ((wgid % nig) % gsz); u.pn = (wgid % nig) / gsz; return true;
  }
};
template <class Epi>
DI void gemm_phase(LAS unsigned char* lds, const Gemm g, const Epi& E, int G_ = -1, int c_ = 0) {
  const int tid = opaque_tid(), wid = __builtin_amdgcn_readfirstlane(tid >> 6), lane = tid & 63, wr = wid >> 2, wc = wid & 3, fr = lane & 15, fq = lane >> 4;
  const int K = g.K, nt = K / BK;
  StaticOrder S; if (G_ > 0) S.init(g.M, g.N, G_, c_); else S.init(g.M, g.N, (int)gridDim.x, (int)blockIdx.x);
  unsigned voffA[2], voffB[2];
#pragma unroll
  for (int i = 0; i < 2; ++i) { int R, C; stage_rc(tid * 16 + i * 8192, R, C);
    const int Rb = Epi::PERM ? ((R & ~31) + perm32(R & 31)) : R;
    voffA[i] = (unsigned)(R * g.lda + C) * 2u; voffB[i] = (unsigned)(Rb * g.ldb + C) * 2u; }
  const size_t kstep = (size_t)(BK * 2);
  const size_t hstepA = (size_t)HALF * g.lda * 2, hstepB = (size_t)HALF * g.ldb * 2;
  const size_t tstepA = 2 * hstepA, tstepB = 2 * hstepB;
  const unsigned ldsw = (unsigned)wid * 1024u;
  const int aoff = lds_byte(wr * 64 + fr, fq * 8), boff = lds_byte(wc * 32 + fr, fq * 8);
#define PG8_SA(b, h) (((b) * 2 + (h)) * HTB)
#define PG8_SB(b, h) ((4 + (b) * 2 + (h)) * HTB)
#define PG8_STAGE(bufoff, gbase, voff) do { _Pragma("unroll") for (int _i = 0; _i < 2; ++_i) \
    __builtin_amdgcn_global_load_lds((const unsigned*)((const char*)(gbase) + (voff)[_i]), (LAS unsigned*)(lds + (bufoff) + ldsw + _i * 8192), 16, 0, 0); } while (0)
#define PG8_LDA(dst, b, h) do { _Pragma("unroll") for (int m = 0; m < 4; ++m) _Pragma("unroll") for (int k = 0; k < 2; ++k) dst[m][k] = *(const LAS bf16x8*)(lds + PG8_SA(b, h) + aoff + m * 2048 + k * 1024); } while (0)
#define PG8_LDB(dst, b, h) do { _Pragma("unroll") for (int n = 0; n < 2; ++n) _Pragma("unroll") for (int k = 0; k < 2; ++k) dst[n][k] = *(const LAS bf16x8*)(lds + PG8_SB(b, h) + boff + n * 2048 + k * 1024); } while (0)
#define PG8_MMA(ai, bj, At, Bt) do { __builtin_amdgcn_s_setprio(1); _Pragma("unroll") for (int m = 0; m < 4; ++m) _Pragma("unroll") for (int n = 0; n < 2; ++n) _Pragma("unroll") for (int k = 0; k < 2; ++k) \
    acc[ai][bj][m][n] = __builtin_amdgcn_mfma_f32_16x16x32_bf16(Bt[n][k], At[m][k], acc[ai][bj][m][n], 0, 0, 0); __builtin_amdgcn_s_setprio(0); } while (0)
#define PG8_WAIT_V(n) asm volatile("s_waitcnt vmcnt(" #n ")" ::: "memory")
#define PG8_WAIT_L(n) asm volatile("s_waitcnt lgkmcnt(" #n ")" ::: "memory")
#define PG8_BAR __builtin_amdgcn_s_barrier()
#define PG8_SCHED __builtin_amdgcn_sched_barrier(0)
  Unit cur, nxt; int ui = 0;
  if (!S.next(0, cur)) return;
  f32x4 acc[2][2][4][2];
#pragma unroll
  for (int a = 0; a < 2; ++a)
#pragma unroll
    for (int b = 0; b < 2; ++b)
#pragma unroll
      for (int m = 0; m < 4; ++m)
#pragma unroll
        for (int n = 0; n < 2; ++n) acc[a][b][m][n] = (f32x4){0.f, 0.f, 0.f, 0.f};
  bf16x8 At[4][2], B0[2][2], B1[2][2];
  const char* cA = (const char*)g.A + (size_t)cur.pm * tstepA; const char* cB = (const char*)g.Bt + (size_t)cur.pn * tstepB;
  PG8_STAGE(PG8_SB(0, 0), cB, voffB); PG8_STAGE(PG8_SA(0, 0), cA, voffA); PG8_STAGE(PG8_SB(0, 1), cB + hstepB, voffB); PG8_STAGE(PG8_SA(0, 1), cA + hstepA, voffA);
  if (wr == 1) PG8_BAR;
  PG8_WAIT_V(4); PG8_BAR;
  PG8_STAGE(PG8_SB(1, 0), cB + kstep, voffB); PG8_STAGE(PG8_SA(1, 0), cA + kstep, voffA); PG8_STAGE(PG8_SB(1, 1), cB + hstepB + kstep, voffB);
  PG8_WAIT_V(6); PG8_BAR;
  for (;;) {
    const bool has_next = S.next(ui + 1, nxt);
    const char* nA = has_next ? (const char*)g.A + (size_t)nxt.pm * tstepA : cA; const char* nB = has_next ? (const char*)g.Bt + (size_t)nxt.pn * tstepB : cB;
    for (int t = 0; t < nt; t += 2) {
      const bool last = (t == nt - 2);
      const char* a1 = cA + (size_t)(t + 1) * kstep;
      const char* a2 = last ? nA : cA + (size_t)(t + 2) * kstep; const char* b2 = last ? nB : cB + (size_t)(t + 2) * kstep;
      const char* a3 = a2 + kstep; const char* b3 = b2 + kstep;
      PG8_LDB(B0, 0, 0); PG8_SCHED; PG8_LDA(At, 0, 0); PG8_STAGE(PG8_SA(1, 1), a1 + hstepA, voffA);
      PG8_WAIT_L(8); PG8_BAR; PG8_WAIT_L(0); PG8_MMA(0, 0, At, B0); PG8_BAR; PG8_SCHED;
      PG8_LDB(B1, 0, 1); PG8_STAGE(PG8_SB(0, 0), b2, voffB);
      PG8_BAR; PG8_WAIT_L(0); PG8_MMA(0, 1, At, B1); PG8_BAR;
      PG8_LDA(At, 0, 1); PG8_STAGE(PG8_SA(0, 0), a2, voffA);
      PG8_BAR; PG8_WAIT_L(0); PG8_MMA(1, 0, At, B0); PG8_BAR; PG8_SCHED;
      PG8_STAGE(PG8_SB(0, 1), b2 + hstepB, voffB);
      PG8_WAIT_V(6); PG8_BAR; PG8_MMA(1, 1, At, B1); PG8_BAR;
      PG8_LDB(B0, 1, 0); PG8_SCHED; PG8_LDA(At, 1, 0); PG8_STAGE(PG8_SA(0, 1), a2 + hstepA, voffA);
      PG8_WAIT_L(8); PG8_BAR; PG8_WAIT_L(0); PG8_MMA(0, 0, At, B0); PG8_BAR; PG8_SCHED;
      PG8_LDB(B1, 1, 1); PG8_STAGE(PG8_SB(1, 0), b3, voffB);
      PG8_BAR; PG8_WAIT_L(0); PG8_MMA(0, 1, At, B1); PG8_BAR;
      PG8_LDA(At, 1, 1); PG8_STAGE(PG8_SA(1, 0), a3, voffA);
      PG8_BAR; PG8_WAIT_L(0); PG8_MMA(1, 0, At, B0); PG8_BAR; PG8_SCHED;
      PG8_STAGE(PG8_SB(1, 1), b3 + hstepB, voffB);
      PG8_WAIT_V(6); PG8_BAR; PG8_MMA(1, 1, At, B1); PG8_BAR;
    }
    E(acc, cur, wr, wc, fr, fq);
    if (!has_next) break;
#pragma unroll
    for (int a = 0; a < 2; ++a)
#pragma unroll
      for (int b = 0; b < 2; ++b)
#pragma unroll
        for (int m = 0; m < 4; ++m)
#pragma unroll
          for (int n = 0; n < 2; ++n) acc[a][b][m][n] = (f32x4){0.f, 0.f, 0.f, 0.f};
    cur = nxt; cA = nA; cB = nB; ++ui;
  }
  PG8_WAIT_V(0);
  if (wr == 0) PG8_BAR;
  PG8_BAR;
#undef PG8_SA
#undef PG8_SB
#undef PG8_STAGE
#undef PG8_LDA
#undef PG8_LDB
#undef PG8_MMA
#undef PG8_WAIT_V
#undef PG8_WAIT_L
#undef PG8_BAR
#undef PG8_SCHED
}
}

#define XB_TMO      128
#define XB_XCNT(j)  (256  + 64 * (j))
#define XB_XSUB(j)  (1280 + 64 * (j))
#define XB_XGEN(j)  (2304 + 64 * (j))
#define XB_TOP      3328
#define XB_TOPGEN   3392
#define XCD_BAR_WORDS 3456
#define XB_SPIN_CAP (1u << 18)
DI unsigned xb_ld(unsigned* p) { return __hip_atomic_load(p, __ATOMIC_RELAXED, __HIP_MEMORY_SCOPE_AGENT); }
DI unsigned xb_add(unsigned* p, unsigned v) { return __hip_atomic_fetch_add(p, v, __ATOMIC_RELAXED, __HIP_MEMORY_SCOPE_AGENT); }
DI unsigned xb_xcc_id() { return (unsigned)__builtin_amdgcn_s_getreg((3 << 11) | 20) & 0xFu; }
#define XB_SPIN(cond, bar) do { unsigned _sp = 0; while (cond) { __builtin_amdgcn_s_sleep(1); \
    if ((++_sp & 255u) == 0u) { if (xb_ld(&(bar)[XB_TMO])) break; if (_sp > XB_SPIN_CAP) { atomicAdd(&(bar)[XB_TMO], 1u); break; } } } } while (0)
struct XcdBarrier { unsigned* bar; unsigned x; volatile LAS unsigned* st; };
DI XcdBarrier xcd_barrier_post(unsigned* bar, volatile LAS unsigned* st) {
  XcdBarrier b; b.bar = bar; b.x = xb_xcc_id(); b.st = st;
  if (threadIdx.x == 0) (void)xb_add(&bar[XB_XCNT(b.x)], 1u);
  return b;
}
DI void xcd_barrier_complete(unsigned* bar, unsigned x, unsigned& nloc, unsigned& nx) {
  const unsigned G = gridDim.x * gridDim.y * gridDim.z;
  unsigned sum, cnt, mine, sp = 0u;
  for (;;) {
    sum = 0u; cnt = 0u; mine = 0u;
#pragma unroll
    for (unsigned j = 0; j < 16; ++j) { const unsigned c = xb_ld(&bar[XB_XCNT(j)]); sum += c; cnt += (c > 0u) ? 1u : 0u; mine = (j == x) ? c : mine; }
    if (sum == G) break;
    __builtin_amdgcn_s_sleep(1);
    if ((++sp & 255u) == 0u) { if (xb_ld(&bar[XB_TMO])) break; if (sp > XB_SPIN_CAP) { atomicAdd(&bar[XB_TMO], 1u); break; } }
  }
  nloc = mine > 0u ? mine : 1u; nx = cnt > 0u ? cnt : 1u;
}
DI void xcd_barrier(const XcdBarrier& b) {
  asm volatile("s_waitcnt vmcnt(0)" ::: "memory");
  __syncthreads();
  if (threadIdx.x == 0) {
    unsigned* bar = b.bar;
    __builtin_amdgcn_s_waitcnt(0);
    unsigned nloc = b.st[0], nx = b.st[1];
    if (nloc == 0u) { xcd_barrier_complete(bar, b.x, nloc, nx); b.st[0] = nloc; b.st[1] = nx; }
    const unsigned old = xb_add(&bar[XB_XSUB(b.x)], 1u);
    const unsigned gen = old / nloc;
    if (old + 1u == (gen + 1u) * nloc) {
      __builtin_amdgcn_fence(__ATOMIC_RELEASE, "agent");
      asm volatile("s_waitcnt vmcnt(0)" ::: "memory");
      const unsigned og = xb_add(&bar[XB_TOP], 1u);
      const unsigned tg = og / nx;
      if (og + 1u == (tg + 1u) * nx) xb_add(&bar[XB_TOPGEN], 1u);
      else XB_SPIN(xb_ld(&bar[XB_TOPGEN]) == tg, bar);
      __builtin_amdgcn_fence(__ATOMIC_ACQUIRE, "agent");
      xb_add(&bar[XB_XGEN(b.x)], 1u);
      asm volatile("s_waitcnt vmcnt(0)" ::: "memory");
    } else {
      XB_SPIN(xb_ld(&bar[XB_XGEN(b.x)]) == gen, bar);
      __builtin_amdgcn_fence(__ATOMIC_ACQUIRE, "agent");
      asm volatile("s_waitcnt vmcnt(0)" ::: "memory");
    }
  }
  __syncthreads();
}

typedef __attribute__((ext_vector_type(4))) short s16x4;
#define TR8(base, o0, o1, o2, o3, o4, o5, o6, o7, r0, r1, r2, r3, r4, r5, r6, r7)                                    \
  asm volatile("ds_read_b64_tr_b16 %0, %8 offset:%9\n\tds_read_b64_tr_b16 %1, %8 offset:%10\n\t"                      \
               "ds_read_b64_tr_b16 %2, %8 offset:%11\n\tds_read_b64_tr_b16 %3, %8 offset:%12\n\t"                     \
               "ds_read_b64_tr_b16 %4, %8 offset:%13\n\tds_read_b64_tr_b16 %5, %8 offset:%14\n\t"                     \
               "ds_read_b64_tr_b16 %6, %8 offset:%15\n\tds_read_b64_tr_b16 %7, %8 offset:%16\n\ts_waitcnt lgkmcnt(0)" \
               : "=&v"(r0), "=&v"(r1), "=&v"(r2), "=&v"(r3), "=&v"(r4), "=&v"(r5), "=&v"(r6), "=&v"(r7)               \
               : "v"(base), "n"(o0), "n"(o1), "n"(o2), "n"(o3), "n"(o4), "n"(o5), "n"(o6), "n"(o7)                    \
               : "memory")
DI bf16x8 cat8(s16x4 lo, s16x4 hi) { return __builtin_shufflevector(lo, hi, 0, 1, 2, 3, 4, 5, 6, 7); }

typedef f32x4 Acc8[2][2][4][2];
#define EPI_FOR                                   \
  _Pragma("unroll") for (int ai = 0; ai < 2; ++ai) \
  _Pragma("unroll") for (int m = 0; m < 4; ++m)    \
  _Pragma("unroll") for (int bj = 0; bj < 2; ++bj) \
  _Pragma("unroll") for (int n = 0; n < 2; ++n)
#define EPI_ROW (u.pm * 256 + ai * 128 + wr * 64 + m * 16 + fr)
#define EPI_COL (u.pn * 256 + bj * 128 + wc * 32 + n * 16 + fq * 4)

#define TILE_VARS                                                                                      \
  const int tid = opaque_tid() & 255, lane = tid & 63, w = tid >> 6, wr = w >> 1, wc = w & 1, fr = lane & 15, \
            fq = lane >> 4;                                                                            \
  (void)tid; (void)lane; (void)w; (void)wr; (void)wc; (void)fr; (void)fq;

DI int map_col(int mode, int n) {
  if (mode == 0) return n;
  if (mode == 1) {
    if (n < 1536) return n;
    if (n < 5120) return n + 16;
    if (n < 5136) return 1536 + (n - 5120);
    return -1;
  }
  int q = n >> 8, s = n & 255;
  return s < 128 ? q * 128 + s : 2816 + q * 128 + (s - 128);
}
DI void transpose_weight(const float* __restrict__ src, int K, int Nsrc, bf16_t* __restrict__ dst, int Ndst, int mode,
                         char* smem, int vb = -1, int vgrid = 0) {
  if (vb < 0) { vb = VB(); vgrid = VGRID(); }
  float* tile = (float*)smem;
  const int tid = opaque_tid() & 255;
  const int nkt = K >> 6, nnt = Ndst >> 6, ntile = nkt * nnt;
  for (int t = vb; t < ntile; t += vgrid) {
    const int kt = t / nnt, nt = t % nnt;
    {
      const int nn = tid & 63, kk0 = tid >> 6;
      const int sc = map_col(mode, nt * 64 + nn);
#pragma unroll
      for (int i = 0; i < 16; i++) {
        const int kk = kk0 + i * 4;
        tile[kk * 65 + nn] = sc >= 0 ? src[(size_t)(kt * 64 + kk) * Nsrc + sc] : 0.f;
      }
    }
    __syncthreads();
    {
      const int kk = (tid & 31) * 2, nn0 = tid >> 5;
#pragma unroll
      for (int i = 0; i < 8; i++) {
        const int nn = nn0 + i * 8;
        *(unsigned*)(dst + (size_t)(nt * 64 + nn) * K + kt * 64 + kk) = pack2(tile[kk * 65 + nn], tile[(kk + 1) * 65 + nn]);
      }
    }
    __syncthreads();
  }
}

template <class SrcFn>
DI void rownorm4_bf16(SrcFn srcfn, int t0, const float* __restrict__ wgt, bf16_t* __restrict__ dst0, int lane) {
  float4 v[4][4];
#pragma unroll
  for (int r = 0; r < 4; r++) {
    const float* src = srcfn(t0 + r);
#pragma unroll
    for (int i = 0; i < 4; i++) v[r][i] = ((const float4*)src)[lane + i * 64];
  }
  float4 ww[4];
#pragma unroll
  for (int i = 0; i < 4; i++) ww[i] = ((const float4*)wgt)[lane + i * 64];
#pragma unroll
  for (int r = 0; r < 4; r++) {
    float ss = 0.f;
#pragma unroll
    for (int i = 0; i < 4; i++) ss += v[r][i].x * v[r][i].x + v[r][i].y * v[r][i].y + v[r][i].z * v[r][i].z + v[r][i].w * v[r][i].w;
    ss = wave_sum(ss);
    const float rs = rsqrtf(ss * (1.f / 1024.f) + 1e-6f);
#pragma unroll
    for (int i = 0; i < 4; i++)
      ((uint2*)(dst0 + (size_t)r * 1024))[lane + i * 64] =
          make_uint2(pack2(v[r][i].x * rs * ww[i].x, v[r][i].y * rs * ww[i].y), pack2(v[r][i].z * rs * ww[i].z, v[r][i].w * rs * ww[i].w));
  }
}

DI void prep_item(const Params& p, int L, int nseq, int nch, int item, char* smem) {
  TILE_VARS
  char* const wsb = opaque_ptr(p.ws);
  bf16_t* Ks = (bf16_t*)smem;
  bf16_t* Qs = (bf16_t*)(smem + 17408);
  bf16_t* Vs = (bf16_t*)(smem + 34816);
  bf16_t* K2 = (bf16_t*)(smem + 53248);
  float* sGc = (float*)(smem + 71680);
  float* sBeta = sGc + 64;
  float* Ls = (float*)Qs;
  bf16_t* Ts = Ks;
  const bf16_t* QKV = (const bf16_t*)(wsb + O_QKV);
  const float* AB = (const float*)(wsb + O_AB);
  bf16_t* WB = (bf16_t*)(wsb + O_WB);
  bf16_t* UB = (bf16_t*)(wsb + O_UB);
  bf16_t* AI = (bf16_t*)(wsb + O_AI);
  float* GC = (float*)(wsb + O_GC);

  const int np = item % nch;
  int tmp = item / nch;
  const int h = tmp & 3;
  tmp >>= 2;
  const int seqi = tmp % nseq, dir = tmp / nseq;
  const int n = dir ? nch - 1 - np : np;
  const int tb = seqi * L + n * 64;

  uint4 kq0, kq1, kq2, kq3, kk[4], kv[4];
  {
    const int r4 = tid >> 4, kc = tid & 15;
    const bf16_t* base = QKV + h * 128 + kc * 8;
    const size_t o0 = (size_t)(tb + (dir ? 63 - r4 : r4)) * 1536, o1 = (size_t)(tb + (dir ? 47 - r4 : r4 + 16)) * 1536;
    const size_t o2 = (size_t)(tb + (dir ? 31 - r4 : r4 + 32)) * 1536, o3 = (size_t)(tb + (dir ? 15 - r4 : r4 + 48)) * 1536;
    kq0 = *(const uint4*)(base + o0); kq1 = *(const uint4*)(base + o1); kq2 = *(const uint4*)(base + o2); kq3 = *(const uint4*)(base + o3);
    kk[0] = *(const uint4*)(base + o0 + 512); kk[1] = *(const uint4*)(base + o1 + 512);
    kk[2] = *(const uint4*)(base + o2 + 512); kk[3] = *(const uint4*)(base + o3 + 512);
    kv[0] = *(const uint4*)(base + o0 + 1024); kv[1] = *(const uint4*)(base + o1 + 1024);
    kv[2] = *(const uint4*)(base + o2 + 1024); kv[3] = *(const uint4*)(base + o3 + 1024);
  }
  if (w == 0) {
    const int tl = tb + (dir ? 63 - lane : lane);
    const float* ab = AB + (size_t)tl * 16;
    const float bet = sigmoidf_(ab[dir * 4 + h]);
    const float xx = ab[8 + dir * 4 + h] + p.dt_bias[dir * 4 + h];
    const float ex = __expf(xx);
    const float sp = xx > 20.f ? xx : (ex < 0.03125f ? ex * (1.f - ex * (0.5f - ex * (0.33333334f - 0.25f * ex))) : __logf(1.f + ex));
    float gv = -__expf(p.a_log[dir * 4 + h]) * sp;
#pragma unroll
    for (int o = 1; o < 64; o <<= 1) {
      const float t = __shfl_up(gv, o);
      if (lane >= o) gv += t;
    }
    sGc[lane] = gv;
    sBeta[lane] = bet;
    GC[(size_t)item * 64 + lane] = gv;
  }
  {
    const int r4 = tid >> 4, kc = tid & 15;
    *(uint4*)(Qs + r4 * 136 + kc * 8) = kq0;
    *(uint4*)(Qs + (r4 + 16) * 136 + kc * 8) = kq1;
    *(uint4*)(Qs + (r4 + 32) * 136 + kc * 8) = kq2;
    *(uint4*)(Qs + (r4 + 48) * 136 + kc * 8) = kq3;
#pragma unroll
    for (int i = 0; i < 4; i++) *(uint4*)(Ks + (r4 + 16 * i) * 136 + kc * 8) = make_uint4(kk[i].x, kk[i].y, kk[i].z, kk[i].w);
  }
  lds_barrier();
#pragma unroll
  for (int i = 0; i < 4; i++) {
    const int id = tid + i * 256, s = id >> 4, kc = id & 15;
    const float b = sBeta[s];
    const float sk = b * __expf(sGc[s]);
    uint4 vo, ko;
    vo.x = pack2(lo2f(kv[i].x) * b, hi2f(kv[i].x) * b); vo.y = pack2(lo2f(kv[i].y) * b, hi2f(kv[i].y) * b);
    vo.z = pack2(lo2f(kv[i].z) * b, hi2f(kv[i].z) * b); vo.w = pack2(lo2f(kv[i].w) * b, hi2f(kv[i].w) * b);
    ko.x = pack2(lo2f(kk[i].x) * sk, hi2f(kk[i].x) * sk); ko.y = pack2(lo2f(kk[i].y) * sk, hi2f(kk[i].y) * sk);
    ko.z = pack2(lo2f(kk[i].z) * sk, hi2f(kk[i].z) * sk); ko.w = pack2(lo2f(kk[i].w) * sk, hi2f(kk[i].w) * sk);
    *(uint4*)(Vs + s * 144 + kc * 8) = vo;
    *(uint4*)(K2 + s * 144 + kc * 8) = ko;
  }
  f32x4 accG[4], accA[4];
#pragma unroll
  for (int j = 0; j < 4; j++) { accG[j] = f32x4{0, 0, 0, 0}; accA[j] = f32x4{0, 0, 0, 0}; }
#pragma unroll
  for (int ks = 0; ks < 4; ks++) {
    const bf16x8 ak = *(const bf16x8*)(Ks + (w * 16 + fr) * 136 + ks * 32 + fq * 8);
    const bf16x8 aq = *(const bf16x8*)(Qs + (w * 16 + fr) * 136 + ks * 32 + fq * 8);
#pragma unroll
    for (int j = 0; j < 4; j++) {
      const bf16x8 b = *(const bf16x8*)(Ks + (j * 16 + fr) * 136 + ks * 32 + fq * 8);
      accG[j] = MFMA(ak, b, accG[j]);
      accA[j] = MFMA(aq, b, accA[j]);
    }
  }
  lds_barrier();
#pragma unroll
  for (int j = 0; j < 4; j++) {
    const int s = j * 16 + fr;
    const float gs = sGc[s];
#pragma unroll
    for (int r = 0; r < 4; r++) {
      const int c = w * 16 + fq * 4 + r;
      const float dec = __expf(fminf(sGc[c] - gs, 0.f));
      Ls[c * 68 + s] = (s < c) ? sBeta[c] * accG[j][r] * dec : 0.f;
      AI[(size_t)item * 4096 + c * 64 + s] = f2bf((s <= c) ? accA[j][r] * dec : 0.f);
    }
  }
  lds_barrier();
  if (w == 0) {
    typedef float f32x2_t __attribute__((ext_vector_type(2)));
    f32x2_t tp[32];
#pragma unroll
    for (int i = 0; i < 64; i++) {
      f32x2_t a0 = {(i == lane) ? 1.f : 0.f, 0.f}, a1 = {0.f, 0.f};
#pragma unroll
      for (int jp = 0; jp < i / 2; jp++) {
        const f32x2_t lv = *(const f32x2_t*)(Ls + i * 68 + 2 * jp);
        if (jp & 1) a1 -= lv * tp[jp]; else a0 -= lv * tp[jp];
      }
      float ti = (a0[0] + a0[1]) + (a1[0] + a1[1]);
      if (i & 1) ti -= Ls[i * 68 + i - 1] * tp[(i - 1) >> 1][0];
      if (i & 1) tp[i >> 1][1] = ti; else tp[i >> 1][0] = ti;
      Ts[i * 72 + lane] = f2bf(ti);
    }
  }
  lds_barrier();
  f32x4 accU[8], accW[8];
#pragma unroll
  for (int j = 0; j < 8; j++) { accU[j] = f32x4{0, 0, 0, 0}; accW[j] = f32x4{0, 0, 0, 0}; }
  {
    const unsigned off = (unsigned)((fq * 8 + (fr >> 2)) * 288 + (fr & 3) * 8);
    const unsigned vb0 = (unsigned)(size_t)Vs + off, kb0 = (unsigned)(size_t)K2 + off;
#pragma unroll
    for (int ks = 0; ks < 2; ks++) {
      const bf16x8 a = *(const bf16x8*)(Ts + (w * 16 + fr) * 72 + ks * 32 + fq * 8);
      s16x4 l0, l1, l2, l3, l4, l5, l6, l7, h0, h1, h2, h3, h4, h5, h6, h7;
      if (ks == 0) {
        TR8(vb0, 0, 32, 64, 96, 128, 160, 192, 224, l0, l1, l2, l3, l4, l5, l6, l7);
        TR8(vb0, 1152, 1184, 1216, 1248, 1280, 1312, 1344, 1376, h0, h1, h2, h3, h4, h5, h6, h7);
      } else {
        TR8(vb0, 9216, 9248, 9280, 9312, 9344, 9376, 9408, 9440, l0, l1, l2, l3, l4, l5, l6, l7);
        TR8(vb0, 10368, 10400, 10432, 10464, 10496, 10528, 10560, 10592, h0, h1, h2, h3, h4, h5, h6, h7);
      }
      accU[0] = MFMA(cat8(l0, h0), a, accU[0]); accU[1] = MFMA(cat8(l1, h1), a, accU[1]);
      accU[2] = MFMA(cat8(l2, h2), a, accU[2]); accU[3] = MFMA(cat8(l3, h3), a, accU[3]);
      accU[4] = MFMA(cat8(l4, h4), a, accU[4]); accU[5] = MFMA(cat8(l5, h5), a, accU[5]);
      accU[6] = MFMA(cat8(l6, h6), a, accU[6]); accU[7] = MFMA(cat8(l7, h7), a, accU[7]);
      if (ks == 0) {
        TR8(kb0, 0, 32, 64, 96, 128, 160, 192, 224, l0, l1, l2, l3, l4, l5, l6, l7);
        TR8(kb0, 1152, 1184, 1216, 1248, 1280, 1312, 1344, 1376, h0, h1, h2, h3, h4, h5, h6, h7);
      } else {
        TR8(kb0, 9216, 9248, 9280, 9312, 9344, 9376, 9408, 9440, l0, l1, l2, l3, l4, l5, l6, l7);
        TR8(kb0, 10368, 10400, 10432, 10464, 10496, 10528, 10560, 10592, h0, h1, h2, h3, h4, h5, h6, h7);
      }
      accW[0] = MFMA(cat8(l0, h0), a, accW[0]); accW[1] = MFMA(cat8(l1, h1), a, accW[1]);
      accW[2] = MFMA(cat8(l2, h2), a, accW[2]); accW[3] = MFMA(cat8(l3, h3), a, accW[3]);
      accW[4] = MFMA(cat8(l4, h4), a, accW[4]); accW[5] = MFMA(cat8(l5, h5), a, accW[5]);
      accW[6] = MFMA(cat8(l6, h6), a, accW[6]); accW[7] = MFMA(cat8(l7, h7), a, accW[7]);
    }
  }
  {
    bf16_t* up = UB + (size_t)item * 8192 + (w * 16 + fr) * 128 + fq * 4;
    bf16_t* wp = WB + (size_t)item * 8192 + (w * 16 + fr) * 128 + fq * 4;
#pragma unroll
    for (int j = 0; j < 8; j++) {
      *(uint2*)(up + j * 16) = pack4(accU[j]);
      *(uint2*)(wp + j * 16) = pack4(accW[j]);
    }
  }
  lds_barrier();
}

DI void sgmix_item(const Params& p, int item, char* smem) {
  TILE_VARS
  char* const wsb = opaque_ptr(p.ws);
  bf16_t* As = (bf16_t*)smem;
  bf16_t* Bs = (bf16_t*)(smem + 34816);
  bf16_t* PROJ = (bf16_t*)(wsb + O_PROJ);
  const float* LNST = (const float*)(wsb + O_LNST);
  const bf16_t* SGW = (const bf16_t*)(wsb + O_SGW);
  const int g = item & 3, cb = item >> 2;
  const int t0 = cb * 128;
#pragma unroll
  for (int i = 0; i < 8; i++) {
    const int id = tid + i * 256, row = id >> 4, cc = id & 15;
    *(uint4*)(As + row * 136 + cc * 8) = *(const uint4*)(SGW + (size_t)g * 16384 + row * 128 + cc * 8);
    const uint4 v = *(const uint4*)(PROJ + (size_t)(t0 + row) * 5120 + 2560 + g * 128 + cc * 8);
    const float mu = LNST[(size_t)(t0 + row) * 2], rstd = LNST[(size_t)(t0 + row) * 2 + 1];
    const unsigned vv[4] = {v.x, v.y, v.z, v.w};
#pragma unroll
    for (int e = 0; e < 4; e++) {
      const int c0 = cc * 8 + 2 * e;
      const float w0 = p.sg_ln_w[g * 128 + c0], w1 = p.sg_ln_w[g * 128 + c0 + 1];
      const float b0 = p.sg_ln_b[g * 128 + c0], b1 = p.sg_ln_b[g * 128 + c0 + 1];
      Bs[c0 * 136 + row] = f2bf((geluf_(lo2f(vv[e])) - mu) * rstd * w0 + b0);
      Bs[(c0 + 1) * 136 + row] = f2bf((geluf_(hi2f(vv[e])) - mu) * rstd * w1 + b1);
    }
  }
  lds_barrier();
  f32x4 acc[4][4];
  zero_acc(acc);
#pragma unroll
  for (int ks = 0; ks < 4; ks++) {
    bf16x8 af[4], bfr[4];
#pragma unroll
    for (int i = 0; i < 4; i++) af[i] = *(const bf16x8*)(As + (wr * 64 + i * 16 + fr) * 136 + ks * 32 + fq * 8);
#pragma unroll
    for (int j = 0; j < 4; j++) bfr[j] = *(const bf16x8*)(Bs + (wc * 64 + j * 16 + fr) * 136 + ks * 32 + fq * 8);
#pragma unroll
    for (int i = 0; i < 4; i++)
#pragma unroll
      for (int j = 0; j < 4; j++) acc[i][j] = MFMA(bfr[j], af[i], acc[i][j]);
  }
  {
    uint2 ur[4][4];
#pragma unroll
    for (int i = 0; i < 4; i++)
#pragma unroll
      for (int j = 0; j < 4; j++)
        ur[i][j] = *(const uint2*)(PROJ + (size_t)(t0 + wr * 64 + i * 16 + fr) * 5120 + 2048 + g * 128 + wc * 64 + j * 16 + fq * 4);
    asm volatile("" ::: "memory");
#pragma unroll
    for (int i = 0; i < 4; i++) {
      const int t = wr * 64 + i * 16 + fr;
      const float bias = p.sg_b[g * 128 + t];
#pragma unroll
      for (int j = 0; j < 4; j++) {
        const int c = wc * 64 + j * 16 + fq * 4;
        const uint2 u = ur[i][j];
        f32x4 o;
        o[0] = geluf_(lo2f(u.x)) * (acc[i][j][0] + bias);
        o[1] = geluf_(hi2f(u.x)) * (acc[i][j][1] + bias);
        o[2] = geluf_(lo2f(u.y)) * (acc[i][j][2] + bias);
        o[3] = geluf_(hi2f(u.y)) * (acc[i][j][3] + bias);
        *(uint2*)(PROJ + (size_t)(t0 + t) * 5120 + 2048 + g * 128 + c) = pack4(o);
      }
    }
  }
  lds_barrier();
}

#define KV_LOAD(SRC)                                                                           \
  kr0 = *(const uint4*)((SRC) + (size_t)(tid >> 5) * 256 + (tid & 31) * 8);                    \
  kr1 = *(const uint4*)((SRC) + (size_t)((tid >> 5) + 8) * 256 + (tid & 31) * 8);              \
  kr2 = *(const uint4*)((SRC) + (size_t)((tid >> 5) + 16) * 256 + (tid & 31) * 8);             \
  kr3 = *(const uint4*)((SRC) + (size_t)((tid >> 5) + 24) * 256 + (tid & 31) * 8);             \
  kr4 = *(const uint4*)((SRC) + (size_t)((tid >> 5) + 32) * 256 + (tid & 31) * 8);             \
  kr5 = *(const uint4*)((SRC) + (size_t)((tid >> 5) + 40) * 256 + (tid & 31) * 8);             \
  kr6 = *(const uint4*)((SRC) + (size_t)((tid >> 5) + 48) * 256 + (tid & 31) * 8);             \
  kr7 = *(const uint4*)((SRC) + (size_t)((tid >> 5) + 56) * 256 + (tid & 31) * 8);
#define KV_STORE()                                                                             \
  *(uint4*)(KVs + ((tid >> 5)) * 264 + (tid & 31) * 8) = kr0;                                  \
  *(uint4*)(KVs + ((tid >> 5) + 8) * 264 + (tid & 31) * 8) = kr1;                              \
  *(uint4*)(KVs + ((tid >> 5) + 16) * 264 + (tid & 31) * 8) = kr2;                             \
  *(uint4*)(KVs + ((tid >> 5) + 24) * 264 + (tid & 31) * 8) = kr3;                             \
  *(uint4*)(KVs + ((tid >> 5) + 32) * 264 + (tid & 31) * 8) = kr4;                             \
  *(uint4*)(KVs + ((tid >> 5) + 40) * 264 + (tid & 31) * 8) = kr5;                             \
  *(uint4*)(KVs + ((tid >> 5) + 48) * 264 + (tid & 31) * 8) = kr6;                             \
  *(uint4*)(KVs + ((tid >> 5) + 56) * 264 + (tid & 31) * 8) = kr7;
DI void attn_item(const Params& p, int item, char* smem) {
  TILE_VARS
  char* const wsb = opaque_ptr(p.ws);
  bf16_t* Qs = (bf16_t*)smem;
  bf16_t* KVs = (bf16_t*)(smem + 33792);
  float* sL = (float*)(smem + 67584);
  bf16_t* Ps = Qs;
  const bf16_t* QX = (const bf16_t*)(wsb + O_QX);
  const bf16_t* KB = (const bf16_t*)(wsb + O_KB);
  const bf16_t* VT = (const bf16_t*)(wsb + O_VT);
  bf16_t* ATT = (bf16_t*)(wsb + O_ATT);
  const int head = item & 3, qt = item >> 2;
  const int t0 = qt * 64;
  const int b = t0 < NPT ? t0 / 8192 : 8 + (t0 - NPT) / 2048;
  const bf16_t* Kp = KB + ((size_t)(b * 4 + head)) * 65536;
  const bf16_t* Vp = VT + ((size_t)(b * 4 + head)) * 65536;
  uint4 kr0, kr1, kr2, kr3, kr4, kr5, kr6, kr7;
  KV_LOAD(Kp)
#pragma unroll
  for (int i = 0; i < 8; i++) {
    const int id = tid + i * 256, row = id >> 5, cc = id & 31;
    *(uint4*)(Qs + row * 264 + cc * 8) = *(const uint4*)(QX + (size_t)(t0 + row) * 1024 + head * 256 + cc * 8);
  }
  f32x4 sc[16];
#pragma unroll
  for (int t = 0; t < 16; t++) sc[t] = f32x4{0, 0, 0, 0};
#pragma unroll
  for (int kc = 0; kc < 4; kc++) {
    lds_barrier();
    KV_STORE()
    if (kc < 3) { KV_LOAD(Kp + (size_t)(kc + 1) * 64 * 256) } else { KV_LOAD(Vp) }
    lds_barrier();
    __builtin_amdgcn_s_setprio(1);
#pragma unroll
    for (int ks = 0; ks < 8; ks++) {
      const bf16x8 a = *(const bf16x8*)(Qs + (w * 16 + fr) * 264 + ks * 32 + fq * 8);
#pragma unroll
      for (int j = 0; j < 4; j++) {
        const bf16x8 bb = *(const bf16x8*)(KVs + (j * 16 + fr) * 264 + ks * 32 + fq * 8);
        sc[kc * 4 + j] = MFMA(a, bb, sc[kc * 4 + j]);
      }
    }
    __builtin_amdgcn_s_setprio(0);
  }
  float lsum[4];
#pragma unroll
  for (int r = 0; r < 4; r++) {
    float m = sc[0][r];
#pragma unroll
    for (int t = 1; t < 16; t++) m = fmaxf(m, sc[t][r]);
    m = max16(m);
    float sm = 0.f;
#pragma unroll
    for (int t = 0; t < 16; t++) {
      const float e = __expf(sc[t][r] - m);
      sc[t][r] = e;
      sm += e;
    }
    lsum[r] = sum16(sm);
  }
  lds_barrier();
  if (fr == 0) {
#pragma unroll
    for (int r = 0; r < 4; r++) sL[w * 16 + fq * 4 + r] = lsum[r];
  }
#pragma unroll
  for (int t = 0; t < 16; t++)
#pragma unroll
    for (int r = 0; r < 4; r++) Ps[(w * 16 + fq * 4 + r) * 264 + t * 16 + fr] = f2bf(sc[t][r]);
#pragma unroll
  for (int dc = 0; dc < 4; dc++) {
    if (dc > 0) lds_barrier();
    KV_STORE()
    if (dc < 3) { KV_LOAD(Vp + (size_t)(dc + 1) * 64 * 256) }
    lds_barrier();
    f32x4 o[4];
#pragma unroll
    for (int j = 0; j < 4; j++) o[j] = f32x4{0, 0, 0, 0};
    __builtin_amdgcn_s_setprio(1);
#pragma unroll
    for (int ks = 0; ks < 8; ks++) {
      const bf16x8 pa = *(const bf16x8*)(Ps + (w * 16 + fr) * 264 + ks * 32 + fq * 8);
#pragma unroll
      for (int j = 0; j < 4; j++) {
        const bf16x8 bb = *(const bf16x8*)(KVs + (j * 16 + fr) * 264 + ks * 32 + fq * 8);
        o[j] = MFMA(bb, pa, o[j]);
      }
    }
    __builtin_amdgcn_s_setprio(0);
    const float linv = 1.f / sL[w * 16 + fr];
#pragma unroll
    for (int j = 0; j < 4; j++) {
      f32x4 v = o[j];
#pragma unroll
      for (int r = 0; r < 4; r++) v[r] *= linv;
      *(uint2*)(ATT + (size_t)(t0 + w * 16 + fr) * 1024 + head * 256 + dc * 64 + j * 16 + fq * 4) = pack4(v);
    }
  }
  lds_barrier();
}
#undef KV_LOAD
#undef KV_STORE

DI void scan_pair16(const Params& p, int L, int nseq, int nch, int chain, int pair, char* lds) {
  TILE_VARS
  const int t5 = opaque_tid();
  const int half = __builtin_amdgcn_readfirstlane(t5 >> 8);
  char* const wsb = opaque_ptr(p.ws);
  char* const own = lds + half * HALF_LDS;
  bf16_t* St = (bf16_t*)own;
  bf16_t* Vnt = (bf16_t*)(own + 8704);
  bf16_t* Vnk = (bf16_t*)(own + 11008);
  bf16_t* Ws = (bf16_t*)(lds + 13312);
  bf16_t* Qs = (bf16_t*)(lds + 30720);
  bf16_t* As = (bf16_t*)(lds + 48128);
  bf16_t* Ks = (bf16_t*)(lds + 57344);
  const bf16_t* QKV = (const bf16_t*)(wsb + O_QKV);
  const bf16_t* WB = (const bf16_t*)(wsb + O_WB);
  const bf16_t* UB = (const bf16_t*)(wsb + O_UB);
  const bf16_t* AI = (const bf16_t*)(wsb + O_AI);
  const float* GC = (const float*)(wsb + O_GC);
  bf16_t* OB = (bf16_t*)(wsb + O_OB);
  const int h = chain & 3;
  const int seqi = (chain >> 2) % nseq, dir = (chain >> 2) / nseq;
  const size_t idx0 = (size_t)chain * nch;
  const int ecol0 = h * 128 + (2 * pair + half) * 16;
  const int r5 = t5 >> 4, c4 = (t5 & 15) * 8;
  const int r6 = t5 >> 3, c3 = (t5 & 7) * 8;

  for (int i = tid; i < 2 * 16 * 136 / 2; i += 256) ((unsigned*)St)[i] = 0u;
  f32x4 accS[2];
  accS[0] = f32x4{0, 0, 0, 0};
  accS[1] = f32x4{0, 0, 0, 0};

  uint4 pw0, pw1, pq0, pq1, pk0, pk1, pa0;
  float pgl, pge;
  float4 pgv;
  bf16_t pu[4];
  auto prefetchA = [&](int np) {
    const size_t idx = idx0 + np;
    const int n = dir ? nch - 1 - np : np;
    const int tb = seqi * L + n * 64;
    pgl = GC[idx * 64 + 63];
    pge = GC[idx * 64 + w * 16 + fr];
    pgv = *(const float4*)(GC + idx * 64 + w * 16 + fq * 4);
    const bf16_t* qb = QKV + h * 128 + c4;
    pq0 = *(const uint4*)(qb + (size_t)(tb + (dir ? 63 - r5 : r5)) * 1536);
    pq1 = *(const uint4*)(qb + (size_t)(tb + (dir ? 31 - r5 : r5 + 32)) * 1536);
    const bf16_t* wb = WB + idx * 8192 + (size_t)r5 * 128 + c4;
    pw0 = *(const uint4*)(wb); pw1 = *(const uint4*)(wb + 32 * 128);
#pragma unroll
    for (int r = 0; r < 4; r++) pu[r] = UB[idx * 8192 + (w * 16 + fq * 4 + r) * 128 + (ecol0 & 127) + fr];
  };
  auto prefetchB = [&](int np) {
    const size_t idx = idx0 + np;
    const int n = dir ? nch - 1 - np : np;
    const int tb = seqi * L + n * 64;
    const bf16_t* kb = QKV + 512 + h * 128 + c4;
    pk0 = *(const uint4*)(kb + (size_t)(tb + (dir ? 63 - r5 : r5)) * 1536);
    pk1 = *(const uint4*)(kb + (size_t)(tb + (dir ? 31 - r5 : r5 + 32)) * 1536);
    pa0 = *(const uint4*)(AI + idx * 4096 + (size_t)r6 * 64 + c3);
  };
  prefetchA(0);
  prefetchB(0);
#pragma unroll 1
  for (int np = 0; np < nch; np++) {
    const int n = dir ? nch - 1 - np : np;
    const int tb = seqi * L + n * 64;
    const float gl = pgl;
    const bf16_t* Sc = St + (np & 1) * (16 * 136);
    bf16_t* Sn = St + ((np + 1) & 1) * (16 * 136);
    *(uint4*)(Ws + r5 * 136 + c4) = pw0;
    *(uint4*)(Ws + (r5 + 32) * 136 + c4) = pw1;
    *(uint4*)(Qs + r5 * 136 + c4) = pq0;
    *(uint4*)(Qs + (r5 + 32) * 136 + c4) = pq1;
    const float eg = __expf(pge);
    const float ek0 = __expf(gl - pgv.x), ek1 = __expf(gl - pgv.y), ek2 = __expf(gl - pgv.z), ek3 = __expf(gl - pgv.w);
    const float ur0 = bf2f(pu[0]), ur1 = bf2f(pu[1]), ur2 = bf2f(pu[2]), ur3 = bf2f(pu[3]);
    if (np + 1 < nch) prefetchA(np + 1);
    lds_barrier();
    f32x4 accV = f32x4{0, 0, 0, 0}, accQ = f32x4{0, 0, 0, 0};
#pragma unroll
    for (int ks = 0; ks < 4; ks++) {
      const bf16x8 aw = *(const bf16x8*)(Ws + (w * 16 + fr) * 136 + ks * 32 + fq * 8);
      const bf16x8 aq = *(const bf16x8*)(Qs + (w * 16 + fr) * 136 + ks * 32 + fq * 8);
      const bf16x8 bb = *(const bf16x8*)(Sc + fr * 136 + ks * 32 + fq * 8);
      accV = MFMA(aw, bb, accV);
      accQ = MFMA(bb, aq, accQ);
    }
    {
      f32x4 vn, vk;
      vn[0] = ur0 - accV[0]; vn[1] = ur1 - accV[1]; vn[2] = ur2 - accV[2]; vn[3] = ur3 - accV[3];
      vk[0] = vn[0] * ek0; vk[1] = vn[1] * ek1; vk[2] = vn[2] * ek2; vk[3] = vn[3] * ek3;
      *(uint2*)(Vnt + fr * 72 + w * 16 + fq * 4) = pack4(vn);
      *(uint2*)(Vnk + fr * 72 + w * 16 + fq * 4) = pack4(vk);
    }
    *(uint4*)(Ks + r5 * 144 + c4) = pk0;
    *(uint4*)(Ks + (r5 + 32) * 144 + c4) = pk1;
    *(uint4*)(As + r6 * 72 + c3) = pa0;
    if (np + 1 < nch) prefetchB(np + 1);
    lds_barrier();
    const float dS = __expf(gl);
#pragma unroll
    for (int r = 0; r < 4; r++) { accS[0][r] *= dS; accS[1][r] *= dS; }
    bf16x8 kfr[2][2];
    {
      const unsigned kb = (unsigned)(size_t)Ks + (unsigned)((fq * 8 + (fr >> 2)) * 288 + (2 * w) * 32 + (fr & 3) * 8);
      s16x4 t0, t1, t2, t3, t4, t5v, t6, t7;
      TR8(kb, 0, 1152, 32, 1184, 9216, 10368, 9248, 10400, t0, t1, t2, t3, t4, t5v, t6, t7);
      kfr[0][0] = cat8(t0, t1); kfr[0][1] = cat8(t2, t3); kfr[1][0] = cat8(t4, t5v); kfr[1][1] = cat8(t6, t7);
    }
    f32x4 accO = f32x4{0, 0, 0, 0};
#pragma unroll
    for (int ks = 0; ks < 2; ks++) {
      const bf16x8 aa = *(const bf16x8*)(As + (w * 16 + fr) * 72 + ks * 32 + fq * 8);
      const bf16x8 bn = *(const bf16x8*)(Vnt + fr * 72 + ks * 32 + fq * 8);
      const bf16x8 bk = *(const bf16x8*)(Vnk + fr * 72 + ks * 32 + fq * 8);
      accO = MFMA(bn, aa, accO);
      accS[0] = MFMA(kfr[ks][0], bk, accS[0]);
      accS[1] = MFMA(kfr[ks][1], bk, accS[1]);
    }
    {
      const int c = w * 16 + fr;
      const int tl = tb + (dir ? 63 - c : c);
      f32x4 o;
#pragma unroll
      for (int r = 0; r < 4; r++) o[r] = eg * accQ[r] + accO[r];
      *(uint2*)(OB + ((size_t)dir * TS + tl) * 512 + ecol0 + fq * 4) = pack4(o);
    }
    *(uint2*)(Sn + fr * 136 + (2 * w) * 16 + fq * 4) = pack4(accS[0]);
    *(uint2*)(Sn + fr * 136 + (2 * w + 1) * 16 + fq * 4) = pack4(accS[1]);
  }
  lds_barrier();
}

template <int NS>
DI void scan_item(const Params& p, int L, int nseq, int nch, int item, char* smem) {
  TILE_VARS
  char* const wsb = opaque_ptr(p.ws);
  bf16_t* St = (bf16_t*)smem;
  bf16_t* Vnt = (bf16_t*)(smem + 8704);
  bf16_t* Ws = (bf16_t*)(smem + 13312);
  bf16_t* Qgs = (bf16_t*)(smem + 30720);
  bf16_t* As = (bf16_t*)(smem + 48128);
  bf16_t* Kg = (bf16_t*)(smem + 57344);
  const bf16_t* QKV = (const bf16_t*)(wsb + O_QKV);
  const bf16_t* WB = (const bf16_t*)(wsb + O_WB);
  const bf16_t* UB = (const bf16_t*)(wsb + O_UB);
  const bf16_t* AI = (const bf16_t*)(wsb + O_AI);
  const float* GC = (const float*)(wsb + O_GC);
  bf16_t* OB = (bf16_t*)(wsb + O_OB);
  constexpr int NSL = 8 / NS;
  const int slice = item % NSL;
  int tmp = item / NSL;
  const int h = tmp & 3;
  tmp >>= 2;
  const int seqi = tmp % nseq, dir = tmp / nseq;
  const size_t idx0 = (size_t)((dir * nseq + seqi) * 4 + h) * nch;
  const int ecol0 = h * 128 + slice * NS * 16;

  for (int i = tid; i < 32 * 136 / 2; i += 256) ((unsigned*)St)[i] = 0u;
  f32x4 accS[2][NS];
#pragma unroll
  for (int a = 0; a < 2; a++)
#pragma unroll
    for (int b = 0; b < NS; b++) accS[a][b] = f32x4{0, 0, 0, 0};

  uint4 pw0, pw1, pw2, pw3, pq[4], pk[4], pa0, pa1;
  float pg[4], pgl;
  bf16_t pu[NS][4];
  auto prefetch = [&](int np) {
    const size_t idx = idx0 + np;
    const int n = dir ? nch - 1 - np : np;
    const int tb = seqi * L + n * 64;
    pgl = GC[idx * 64 + 63];
#pragma unroll
    for (int i = 0; i < 4; i++) {
      const int id = tid + i * 256, row = id >> 4, kc = id & 15;
      const int tl = tb + (dir ? 63 - row : row);
      const bf16_t* base = QKV + (size_t)tl * 1536 + h * 128 + kc * 8;
      pq[i] = *(const uint4*)(base);
      pk[i] = *(const uint4*)(base + 512);
      pg[i] = GC[idx * 64 + row];
    }
    pw0 = *(const uint4*)(WB + idx * 8192 + (size_t)(tid >> 4) * 128 + (tid & 15) * 8);
    pw1 = *(const uint4*)(WB + idx * 8192 + (size_t)((tid >> 4) + 16) * 128 + (tid & 15) * 8);
    pw2 = *(const uint4*)(WB + idx * 8192 + (size_t)((tid >> 4) + 32) * 128 + (tid & 15) * 8);
    pw3 = *(const uint4*)(WB + idx * 8192 + (size_t)((tid >> 4) + 48) * 128 + (tid & 15) * 8);
    pa0 = *(const uint4*)(AI + idx * 4096 + (size_t)(tid >> 3) * 64 + (tid & 7) * 8);
    pa1 = *(const uint4*)(AI + idx * 4096 + (size_t)((tid >> 3) + 32) * 64 + (tid & 7) * 8);
#pragma unroll
    for (int j = 0; j < NS; j++)
#pragma unroll
      for (int r = 0; r < 4; r++) pu[j][r] = UB[idx * 8192 + (w * 16 + fq * 4 + r) * 128 + (ecol0 & 127) + j * 16 + fr];
  };
  prefetch(0);
#pragma unroll 1
  for (int np = 0; np < nch; np++) {
    const int n = dir ? nch - 1 - np : np;
    const int tb = seqi * L + n * 64;
    const float gl = pgl;
#pragma unroll
    for (int i = 0; i < 4; i++) {
      const int id = tid + i * 256, row = id >> 4, kc = id & 15;
      const float eg = __expf(pg[i]), ek = __expf(gl - pg[i]);
      const uint4 q = pq[i], k = pk[i];
      uint4 qo;
      qo.x = pack2(lo2f(q.x) * eg, hi2f(q.x) * eg);
      qo.y = pack2(lo2f(q.y) * eg, hi2f(q.y) * eg);
      qo.z = pack2(lo2f(q.z) * eg, hi2f(q.z) * eg);
      qo.w = pack2(lo2f(q.w) * eg, hi2f(q.w) * eg);
      *(uint4*)(Qgs + row * 136 + kc * 8) = qo;
      uint4 ko;
      ko.x = pack2(lo2f(k.x) * ek, hi2f(k.x) * ek);
      ko.y = pack2(lo2f(k.y) * ek, hi2f(k.y) * ek);
      ko.z = pack2(lo2f(k.z) * ek, hi2f(k.z) * ek);
      ko.w = pack2(lo2f(k.w) * ek, hi2f(k.w) * ek);
      *(uint4*)(Kg + row * 144 + kc * 8) = ko;
    }
    *(uint4*)(Ws + (tid >> 4) * 136 + (tid & 15) * 8) = pw0;
    *(uint4*)(Ws + ((tid >> 4) + 16) * 136 + (tid & 15) * 8) = pw1;
    *(uint4*)(Ws + ((tid >> 4) + 32) * 136 + (tid & 15) * 8) = pw2;
    *(uint4*)(Ws + ((tid >> 4) + 48) * 136 + (tid & 15) * 8) = pw3;
    *(uint4*)(As + (tid >> 3) * 72 + (tid & 7) * 8) = pa0;
    *(uint4*)(As + ((tid >> 3) + 32) * 72 + (tid & 7) * 8) = pa1;
    float ureg[NS][4];
#pragma unroll
    for (int j = 0; j < NS; j++)
#pragma unroll
      for (int r = 0; r < 4; r++) ureg[j][r] = bf2f(pu[j][r]);
    if (np + 1 < nch) prefetch(np + 1);
    lds_barrier();
    f32x4 accV[NS], accO[NS];
#pragma unroll
    for (int j = 0; j < NS; j++) { accV[j] = f32x4{0, 0, 0, 0}; accO[j] = f32x4{0, 0, 0, 0}; }
#pragma unroll
    for (int ks = 0; ks < 4; ks++) {
      const bf16x8 aw = *(const bf16x8*)(Ws + (w * 16 + fr) * 136 + ks * 32 + fq * 8);
      const bf16x8 aq = *(const bf16x8*)(Qgs + (w * 16 + fr) * 136 + ks * 32 + fq * 8);
#pragma unroll
      for (int j = 0; j < NS; j++) {
        const bf16x8 b = *(const bf16x8*)(St + (j * 16 + fr) * 136 + ks * 32 + fq * 8);
        accV[j] = MFMA(aw, b, accV[j]);
        accO[j] = MFMA(b, aq, accO[j]);
      }
    }
#pragma unroll
    for (int j = 0; j < NS; j++) {
      f32x4 vn;
#pragma unroll
      for (int r = 0; r < 4; r++) vn[r] = ureg[j][r] - accV[j][r];
      *(uint2*)(Vnt + (j * 16 + fr) * 72 + w * 16 + fq * 4) = pack4(vn);
    }
    lds_barrier();
    const float dS = __expf(gl);
#pragma unroll
    for (int a = 0; a < 2; a++)
#pragma unroll
      for (int b = 0; b < NS; b++)
#pragma unroll
        for (int r = 0; r < 4; r++) accS[a][b][r] *= dS;
    bf16x8 kfr[2][2];
    {
      const unsigned kb = (unsigned)(size_t)Kg + (unsigned)((fq * 8 + (fr >> 2)) * 288 + (2 * w) * 32 + (fr & 3) * 8);
      s16x4 t0, t1, t2, t3, t4, t5, t6, t7;
      TR8(kb, 0, 1152, 32, 1184, 9216, 10368, 9248, 10400, t0, t1, t2, t3, t4, t5, t6, t7);
      kfr[0][0] = cat8(t0, t1); kfr[0][1] = cat8(t2, t3); kfr[1][0] = cat8(t4, t5); kfr[1][1] = cat8(t6, t7);
    }
#pragma unroll
    for (int ks = 0; ks < 2; ks++) {
      const bf16x8 aa = *(const bf16x8*)(As + (w * 16 + fr) * 72 + ks * 32 + fq * 8);
#pragma unroll
      for (int j = 0; j < NS; j++) {
        const bf16x8 b = *(const bf16x8*)(Vnt + (j * 16 + fr) * 72 + ks * 32 + fq * 8);
        accO[j] = MFMA(b, aa, accO[j]);
        accS[0][j] = MFMA(kfr[ks][0], b, accS[0][j]);
        accS[1][j] = MFMA(kfr[ks][1], b, accS[1][j]);
      }
    }
    {
      const int c = w * 16 + fr;
      const int tl = tb + (dir ? 63 - c : c);
#pragma unroll
      for (int j = 0; j < NS; j++)
        *(uint2*)(OB + ((size_t)dir * TS + tl) * 512 + ecol0 + j * 16 + fq * 4) = pack4(accO[j]);
    }
    lds_barrier();
#pragma unroll
    for (int mi = 0; mi < 2; mi++)
#pragma unroll
      for (int j = 0; j < NS; j++)
        *(uint2*)(St + (j * 16 + fr) * 136 + (2 * w + mi) * 16 + fq * 4) = pack4(accS[mi][j]);
  }
  lds_barrier();
}

using pg8::Unit;
#define EPI_FOR8                                    \
  _Pragma("unroll") for (int ai = 0; ai < 2; ++ai)  \
  _Pragma("unroll") for (int m = 0; m < 4; ++m)     \
  _Pragma("unroll") for (int bj = 0; bj < 2; ++bj)
#define EPI_COL8 (u.pn * 256 + bj * 128 + wc * 32 + fq * 8)
DI uint4 pack8(const f32x4& a, const f32x4& b) { return make_uint4(pack2(a[0], a[1]), pack2(a[2], a[3]), pack2(b[0], b[1]), pack2(b[2], b[3])); }
DI void unpack8(const uint4& g, float (&f)[8]) {
  f[0] = lo2f(g.x); f[1] = hi2f(g.x); f[2] = lo2f(g.y); f[3] = hi2f(g.y);
  f[4] = lo2f(g.z); f[5] = hi2f(g.z); f[6] = lo2f(g.w); f[7] = hi2f(g.w);
}
struct EpiKV {
  static constexpr bool PERM = true;
  bf16_t* KB; bf16_t* VT;
  DI void operator()(const Acc8& acc, const Unit& u, int wr, int wc, int fr, int fq) const {
    EPI_FOR8 {
      const int row = EPI_ROW, col = EPI_COL8;
      const int b = row >> 8, mm = row & 255;
      const f32x4 v0 = acc[ai][bj][m][0], v1 = acc[ai][bj][m][1];
      if (col < 1024) {
        const int hh = col >> 8, d = col & 255;
        *(uint4*)(KB + ((size_t)(b * 4 + hh) * 256 + mm) * 256 + d) = pack8(v0, v1);
      } else {
        const int c2 = col - 1024, hh = c2 >> 8, d = c2 & 255;
#pragma unroll
        for (int r = 0; r < 4; r++) {
          VT[((size_t)(b * 4 + hh) * 256 + d + r) * 256 + mm] = f2bf(v0[r]);
          VT[((size_t)(b * 4 + hh) * 256 + d + 4 + r) * 256 + mm] = f2bf(v1[r]);
        }
      }
    }
  }
};
struct EpiProj {
  static constexpr bool PERM = true;
  bf16_t* PROJ; float* AB;
  DI void operator()(const Acc8& acc, const Unit& u, int wr, int wc, int fr, int fq) const {
    if (u.pn == 20) {
      if (wc == 0 && fq < 2) {
#pragma unroll
        for (int ai = 0; ai < 2; ++ai)
#pragma unroll
          for (int m = 0; m < 4; ++m) {
            const int row = u.pm * 256 + ai * 128 + wr * 64 + m * 16 + fr;
            const f32x4 v0 = acc[ai][0][m][0], v1 = acc[ai][0][m][1];
            *(float4*)(AB + (size_t)row * 16 + fq * 8) = make_float4(v0[0], v0[1], v0[2], v0[3]);
            *(float4*)(AB + (size_t)row * 16 + fq * 8 + 4) = make_float4(v1[0], v1[1], v1[2], v1[3]);
          }
      }
      return;
    }
    const int mode = u.pn >= 12 ? 3 : 0;
    EPI_FOR8 {
      const int row = EPI_ROW, col = EPI_COL8;
      f32x4 v0 = acc[ai][bj][m][0], v1 = acc[ai][bj][m][1];
      if (mode == 3) {
#pragma unroll
        for (int r = 0; r < 4; r++) { v0[r] = sigmoidf_(v0[r]); v1[r] = sigmoidf_(v1[r]); }
      } else if (mode == 2) {
#pragma unroll
        for (int r = 0; r < 4; r++) { v0[r] = geluf_(v0[r]); v1[r] = geluf_(v1[r]); }
      } else if (mode == 1) {
#pragma unroll
        for (int r = 0; r < 4; r++) { v0[r] = siluf_(v0[r]); v1[r] = siluf_(v1[r]); }
      }
      *(uint4*)(PROJ + (size_t)row * 5120 + col) = pack8(v0, v1);
    }
  }
};
template <int PASS>
struct EpiMerge {
  static constexpr bool PERM = true;
  const bf16_t* PROJ; bf16_t* MERGED;
  DI void operator()(const Acc8& acc, const Unit& u, int wr, int wc, int fr, int fq) const {
#pragma unroll
    for (int ai = 0; ai < 2; ++ai) {
      uint4 gr[4][2], mr[4][2];
#pragma unroll
      for (int m = 0; m < 4; ++m)
#pragma unroll
        for (int bj = 0; bj < 2; ++bj) {
          gr[m][bj] = *(const uint4*)(PROJ + (size_t)EPI_ROW * 5120 + (PASS ? 4096 : 3072) + EPI_COL8);
          if (PASS) mr[m][bj] = *(const uint4*)(MERGED + (size_t)EPI_ROW * 1024 + EPI_COL8);
        }
      asm volatile("" ::: "memory");
#pragma unroll
      for (int m = 0; m < 4; ++m)
#pragma unroll
        for (int bj = 0; bj < 2; ++bj) {
          float g[8];
          unpack8(gr[m][bj], g);
          f32x4 v0 = acc[ai][bj][m][0], v1 = acc[ai][bj][m][1];
#pragma unroll
          for (int r = 0; r < 4; r++) { v0[r] *= g[r]; v1[r] *= g[4 + r]; }
          if (PASS) {
            float mo[8];
            unpack8(mr[m][bj], mo);
#pragma unroll
            for (int r = 0; r < 4; r++) { v0[r] += mo[r]; v1[r] += mo[4 + r]; }
          }
          *(uint4*)(MERGED + (size_t)EPI_ROW * 1024 + EPI_COL8) = pack8(v0, v1);
        }
    }
  }
};
struct EpiWout {
  static constexpr bool PERM = false;
  const float* xin; float* out;
  DI void operator()(const Acc8& acc, const Unit& u, int wr, int wc, int fr, int fq) const {
#pragma unroll
    for (int ai = 0; ai < 2; ++ai) {
      float4 xi[4][2][2];
#pragma unroll
      for (int m = 0; m < 4; ++m)
#pragma unroll
        for (int bj = 0; bj < 2; ++bj)
#pragma unroll
          for (int n = 0; n < 2; ++n) xi[m][bj][n] = *(const float4*)(xin + (size_t)EPI_ROW * 1024 + EPI_COL);
      asm volatile("" ::: "memory");
#pragma unroll
      for (int m = 0; m < 4; ++m)
#pragma unroll
        for (int bj = 0; bj < 2; ++bj)
#pragma unroll
          for (int n = 0; n < 2; ++n) {
            const f32x4 v = acc[ai][bj][m][n];
            const float4 x = xi[m][bj][n];
            *(float4*)(out + (size_t)EPI_ROW * 1024 + EPI_COL) = make_float4(x.x + v[0], x.y + v[1], x.z + v[2], x.w + v[3]);
          }
    }
  }
};
struct EpiQ {
  static constexpr bool PERM = true;
  bf16_t* QX;
  DI void operator()(const Acc8& acc, const Unit& u, int wr, int wc, int fr, int fq) const {
    EPI_FOR8 {
      f32x4 v0 = acc[ai][bj][m][0], v1 = acc[ai][bj][m][1];
#pragma unroll
      for (int r = 0; r < 4; r++) { v0[r] *= 0.0625f; v1[r] *= 0.0625f; }
      *(uint4*)(QX + (size_t)EPI_ROW * 1024 + EPI_COL8) = pack8(v0, v1);
    }
  }
};
struct EpiGateUp {
  static constexpr bool PERM = true;
  bf16_t* ACT;
  DI void operator()(const Acc8& acc, const Unit& u, int wr, int wc, int fr, int fq) const {
#pragma unroll
    for (int ai = 0; ai < 2; ++ai)
#pragma unroll
      for (int m = 0; m < 4; ++m) {
        const int row = u.pm * 256 + ai * 128 + wr * 64 + m * 16 + fr;
        const int col = u.pn * 128 + wc * 32 + fq * 8;
        f32x4 v0, v1;
#pragma unroll
        for (int r = 0; r < 4; r++) {
          v0[r] = siluf_(acc[ai][0][m][0][r]) * acc[ai][1][m][0][r];
          v1[r] = siluf_(acc[ai][0][m][1][r]) * acc[ai][1][m][1][r];
        }
        *(uint4*)(ACT + (size_t)row * 2816 + col) = pack8(v0, v1);
      }
  }
};

#define GW_VARS const int gw = VB() * 4 + w, nw = VGRID() * 4;

DI void phase_prologue(const Params& p, char* smem) {
  char* ws = opaque_ptr(p.ws);
  transpose_weight(p.w_in, 1024, 5136, (bf16_t*)(ws + O_WIN), 5376, 1, smem);
  transpose_weight(p.xa_w_kv, 1024, 2048, (bf16_t*)(ws + O_WKV), 2048, 0, smem);
  TILE_VARS
  GW_VARS
  bf16_t* SGW = (bf16_t*)(ws + O_SGW);
  for (int i = VB() * 256 + tid; i < 65536; i += VGRID() * 256) SGW[i] = f2bf(p.sg_w[i]);
  bf16_t* HB = (bf16_t*)(ws + O_HB);
  for (int t = gw * 4; t < TS; t += nw * 4)
    rownorm4_bf16([&](int tt) { return xrow(p, tt); }, t, p.norm_mix_w, HB + (size_t)t * 1024, lane);
  bf16_t* MEMN = (bf16_t*)(ws + O_MEMN);
  for (int t = gw * 4; t < 6144; t += nw * 4)
    rownorm4_bf16([&](int tt) { return tt < 2048 ? p.mem_prompt + (size_t)tt * 1024 : p.mem_sample + (size_t)(tt - 2048) * 1024; }, t,
                  p.norm_mem_w, MEMN + (size_t)t * 1024, lane);
}

DI void phase_conv(const Params& p, int L) {
  TILE_VARS
  GW_VARS
  char* ws = opaque_ptr(p.ws);
  const bf16_t* PROJ = (const bf16_t*)(ws + O_PROJ);
  bf16_t* QKV = (bf16_t*)(ws + O_QKV);
  float* LNST = (float*)(ws + O_LNST);
  const int nItems = 3 * (TS / 16);
  for (int item = gw; item < nItems; item += nw) {
    const int g = item % 3, run = item / 3;
    const int t0 = run * 16;
    const int seqb = (t0 / L) * L, l0 = t0 - seqb;
    const int ch = g * 512 + lane * 8;
    float cw[5][8];
#pragma unroll
    for (int j = 0; j < 5; j++) {
      const float4 a = *(const float4*)(p.conv_w + j * 1536 + ch);
      const float4 b = *(const float4*)(p.conv_w + j * 1536 + ch + 4);
      cw[j][0] = a.x; cw[j][1] = a.y; cw[j][2] = a.z; cw[j][3] = a.w;
      cw[j][4] = b.x; cw[j][5] = b.y; cw[j][6] = b.z; cw[j][7] = b.w;
    }
    uint4 raw[20];
#pragma unroll
    for (int j = 0; j < 20; j++) {
      const int l = l0 - 2 + j;
      raw[j] = (l >= 0 && l < L) ? *(const uint4*)(PROJ + (size_t)(seqb + l) * 5120 + ch) : make_uint4(0u, 0u, 0u, 0u);
    }
#pragma unroll
    for (int tt = 0; tt < 16; tt++) {
      float o[8];
#pragma unroll
      for (int e = 0; e < 8; e++) o[e] = 0.f;
#pragma unroll
      for (int j = 0; j < 5; j++) {
        const uint4 v = raw[tt + j];
        o[0] += cw[j][0] * lo2f(v.x); o[1] += cw[j][1] * hi2f(v.x); o[2] += cw[j][2] * lo2f(v.y); o[3] += cw[j][3] * hi2f(v.y);
        o[4] += cw[j][4] * lo2f(v.z); o[5] += cw[j][5] * hi2f(v.z); o[6] += cw[j][6] * lo2f(v.w); o[7] += cw[j][7] * hi2f(v.w);
      }
      float ss = 0.f;
#pragma unroll
      for (int e = 0; e < 8; e++) {
        o[e] = siluf_(o[e]);
        ss += o[e] * o[e];
      }
      if (g < 2) {
        ss = sum16(ss);
        const float sc = rsqrtf(ss + 1e-6f) * (g == 0 ? 0.08838834764831845f : 1.f);
#pragma unroll
        for (int e = 0; e < 8; e++) o[e] *= sc;
      }
      uint4 pk;
      pk.x = pack2(o[0], o[1]); pk.y = pack2(o[2], o[3]); pk.z = pack2(o[4], o[5]); pk.w = pack2(o[6], o[7]);
      *(uint4*)(QKV + (size_t)(t0 + tt) * 1536 + ch) = pk;
    }
  }
  for (int t = gw * 4; t < TS; t += nw * 4) {
    uint4 vv[4];
#pragma unroll
    for (int r = 0; r < 4; r++) vv[r] = *(const uint4*)(PROJ + (size_t)(t + r) * 5120 + 2560 + lane * 8);
#pragma unroll
    for (int r = 0; r < 4; r++) {
      const uint4 v = vv[r];
      float f[8] = {geluf_(lo2f(v.x)), geluf_(hi2f(v.x)), geluf_(lo2f(v.y)), geluf_(hi2f(v.y)),
                    geluf_(lo2f(v.z)), geluf_(hi2f(v.z)), geluf_(lo2f(v.w)), geluf_(hi2f(v.w))};
      float sm = 0.f;
#pragma unroll
      for (int e = 0; e < 8; e++) sm += f[e];
      const float mu = wave_sum(sm) * (1.f / 512.f);
      float q = 0.f;
#pragma unroll
      for (int e = 0; e < 8; e++) q += (f[e] - mu) * (f[e] - mu);
      const float var = wave_sum(q) * (1.f / 512.f);
      if (lane == 0) {
        LNST[(size_t)(t + r) * 2] = mu;
        LNST[(size_t)(t + r) * 2 + 1] = rsqrtf(var + 1e-6f);
      }
    }
  }
}

DI void phase_dnout(const Params& p) {
  TILE_VARS
  GW_VARS
  char* ws = opaque_ptr(p.ws);
  const bf16_t* PROJ = (const bf16_t*)(ws + O_PROJ);
  const bf16_t* OB = (const bf16_t*)(ws + O_OB);
  bf16_t* DNO = (bf16_t*)(ws + O_DNO);
  const float4 nw0 = *(const float4*)(p.dn_norm_w + (lane & 15) * 8);
  const float4 nw1 = *(const float4*)(p.dn_norm_w + (lane & 15) * 8 + 4);
  const float nwv[8] = {nw0.x, nw0.y, nw0.z, nw0.w, nw1.x, nw1.y, nw1.z, nw1.w};
  for (int t4 = gw * 4; t4 < TS; t4 += nw * 4) {
    uint4 av[4], bv[4], gv[4];
#pragma unroll
    for (int r = 0; r < 4; r++) {
      av[r] = *(const uint4*)(OB + (size_t)(t4 + r) * 512 + lane * 8);
      bv[r] = *(const uint4*)(OB + ((size_t)TS + t4 + r) * 512 + lane * 8);
      gv[r] = *(const uint4*)(PROJ + (size_t)(t4 + r) * 5120 + 1536 + lane * 8);
    }
#pragma unroll
    for (int r = 0; r < 4; r++) {
      const uint4 a = av[r], b = bv[r], gt = gv[r];
      float o[8] = {lo2f(a.x) + lo2f(b.x), hi2f(a.x) + hi2f(b.x), lo2f(a.y) + lo2f(b.y), hi2f(a.y) + hi2f(b.y),
                    lo2f(a.z) + lo2f(b.z), hi2f(a.z) + hi2f(b.z), lo2f(a.w) + lo2f(b.w), hi2f(a.w) + hi2f(b.w)};
      const float gg[8] = {siluf_(lo2f(gt.x)), siluf_(hi2f(gt.x)), siluf_(lo2f(gt.y)), siluf_(hi2f(gt.y)),
                           siluf_(lo2f(gt.z)), siluf_(hi2f(gt.z)), siluf_(lo2f(gt.w)), siluf_(hi2f(gt.w))};
      float ss = 0.f;
#pragma unroll
      for (int e = 0; e < 8; e++) ss += o[e] * o[e];
      ss = sum16(ss);
      const float rs = rsqrtf(ss * (1.f / 128.f) + 1e-6f);
#pragma unroll
      for (int e = 0; e < 8; e++) o[e] = o[e] * rs * nwv[e] * gg[e];
      uint4 pk;
      pk.x = pack2(o[0], o[1]); pk.y = pack2(o[2], o[3]); pk.z = pack2(o[4], o[5]); pk.w = pack2(o[6], o[7]);
      *(uint4*)(DNO + (size_t)(t4 + r) * 512 + lane * 8) = pk;
    }
  }
}

DI void phase_norm_out(const Params& p, const float* wgt) {
  TILE_VARS
  GW_VARS
  bf16_t* HB = (bf16_t*)(opaque_ptr(p.ws) + O_HB);
  const float* outp = p.out;
  for (int t = gw * 4; t < NTOK; t += nw * 4)
    rownorm4_bf16([&](int tt) { return outp + (size_t)tt * 1024; }, t, wgt, HB + (size_t)t * 1024, lane);
}

DI void phase_final(const Params& p) {
  TILE_VARS
  GW_VARS
  float4 ww[4];
#pragma unroll
  for (int i = 0; i < 4; i++) ww[i] = ((const float4*)p.final_norm_w)[lane + i * 64];
  for (int t = gw * 4; t < NTOK; t += nw * 4) {
    float* rowp = p.out + (size_t)t * 1024;
    float4 v[4][4];
#pragma unroll
    for (int r = 0; r < 4; r++)
#pragma unroll
      for (int i = 0; i < 4; i++) v[r][i] = ((const float4*)(rowp + r * 1024))[lane + i * 64];
#pragma unroll
    for (int r = 0; r < 4; r++) {
      float ss = 0.f;
#pragma unroll
      for (int i = 0; i < 4; i++) ss += v[r][i].x * v[r][i].x + v[r][i].y * v[r][i].y + v[r][i].z * v[r][i].z + v[r][i].w * v[r][i].w;
      ss = wave_sum(ss);
      const float rs = rsqrtf(ss * (1.f / 1024.f) + 1e-6f);
#pragma unroll
      for (int i = 0; i < 4; i++)
        ((float4*)(rowp + r * 1024))[lane + i * 64] =
            make_float4(v[r][i].x * rs * ww[i].x, v[r][i].y * rs * ww[i].y, v[r][i].z * rs * ww[i].z, v[r][i].w * rs * ww[i].w);
    }
  }
}

__global__ void __launch_bounds__(512, 2) fwd_megakernel(Params p) {
  extern __shared__ __attribute__((aligned(16))) char dyn_smem[];
  cg::grid_group grid = cg::this_grid();
  LAS unsigned char* glds = (LAS unsigned char*)dyn_smem;
  char* smem = dyn_smem + __builtin_amdgcn_readfirstlane(threadIdx.x >> 8) * HALF_LDS;
  char* ws = opaque_ptr(p.ws);
  const bf16_t* HB = (const bf16_t*)(ws + O_HB);
  volatile LAS unsigned* xst = (volatile LAS unsigned*)(glds + LDS_BYTES);
  if (threadIdx.x == 0) { xst[0] = 0u; xst[1] = 0u; }
  __syncthreads();
  const XcdBarrier xb = xcd_barrier_post((unsigned*)(ws + O_BAR), xst);

  phase_prologue(p, smem);
  grid.sync();
#pragma unroll 1
  for (int slab = 0; slab < 3; slab++) {
    const int tok0 = slab * TS;
    const int L = slab < 2 ? 8192 : 2048;
    const int nseq = slab < 2 ? 4 : 16;
    const int nch = L / 64;
    {
      EpiProj E{(bf16_t*)(ws + O_PROJ), (float*)(ws + O_AB)};
      pg8::gemm_phase(glds, pg8::Gemm{HB + (size_t)tok0 * 1024, (const bf16_t*)(ws + O_WIN), TS, 5376, 1024, 1024, 1024}, E);
    }
    xcd_barrier(xb);
    phase_conv(p, L);
    xcd_barrier(xb);
    {
      const int nPrep = 2 * nseq * 4 * nch;
#pragma unroll 1
      for (int item = VB(); item < nPrep; item += VGRID()) prep_item(p, L, nseq, nch, item, smem);
      if (slab == 2) {
#pragma unroll 1
        for (int item = VB(); item < 1024; item += VGRID()) sgmix_item(p, item, smem);
      }
    }
    xcd_barrier(xb);
    if (slab < 2) {
      const int nScan = 2 * nseq * 4 * 8;
      if (VB() < nScan) {
        const int bx = blockIdx.x, xcd = bx & 7, j = bx >> 3;
        const int chain = (j >> 2) * 8 + xcd;
        scan_pair16(p, L, nseq, nch, chain, j & 3, dyn_smem);
      } else {
#pragma unroll 1
        for (int item = VB() - nScan; item < 1024; item += VGRID() - nScan) sgmix_item(p, item, smem);
        {
          const int vb_ = VB() - nScan, vg_ = VGRID() - nScan;
          const int tid_ = opaque_tid() & 255, lane_ = tid_ & 63, w_ = tid_ >> 6;
          const int gw_ = vb_ * 4 + w_, nw_ = vg_ * 4;
          bf16_t* HBw = (bf16_t*)(ws + O_HB);
          if (slab == 0) {
            transpose_weight(p.w_up_a, 512, 1024, (bf16_t*)(ws + O_WUPA), 1024, 0, smem, vb_, vg_);
            transpose_weight(p.w_up_b, 512, 1024, (bf16_t*)(ws + O_WUPB), 1024, 0, smem, vb_, vg_);
            transpose_weight(p.w_out, 1024, 1024, (bf16_t*)(ws + O_WOUT), 1024, 0, smem, vb_, vg_);
            const int nIdle = (int)gridDim.x - nScan / 2;
            EpiKV E{(bf16_t*)(ws + O_KB), (bf16_t*)(ws + O_VT)};
            pg8::gemm_phase(glds, pg8::Gemm{(const bf16_t*)(ws + O_MEMN), (const bf16_t*)(ws + O_WKV), 6144, 2048, 1024, 1024, 1024}, E, nIdle,
                            (int)blockIdx.x - nScan / 2);
            for (int t = TS + gw_ * 4; t < 2 * TS; t += nw_ * 4)
              rownorm4_bf16([&](int tt) { return xrow(p, tt); }, t, p.norm_mix_w, HBw + (size_t)t * 1024, lane_);
          } else {
            transpose_weight(p.xa_w_q, 1024, 1024, (bf16_t*)(ws + O_WQ), 1024, 0, smem, vb_, vg_);
            transpose_weight(p.xa_w_o, 1024, 1024, (bf16_t*)(ws + O_WO), 1024, 0, smem, vb_, vg_);
            transpose_weight(p.ffn_w_gu, 1024, 5632, (bf16_t*)(ws + O_WGU), 5632, 2, smem, vb_, vg_);
            transpose_weight(p.ffn_w_down, 2816, 1024, (bf16_t*)(ws + O_WDN), 1024, 0, smem, vb_, vg_);
            for (int t = 2 * TS + gw_ * 4; t < NTOK; t += nw_ * 4)
              rownorm4_bf16([&](int tt) { return xrow(p, tt); }, t, p.norm_mix_w, HBw + (size_t)t * 1024, lane_);
          }
        }
      }
    } else {
      const int bx = blockIdx.x, xcd = bx & 7, j = bx >> 3;
      const int chain = (j >> 1) * 8 + xcd, slice = 2 * (j & 1) + __builtin_amdgcn_readfirstlane(threadIdx.x >> 8);
      scan_item<2>(p, L, nseq, nch, chain * 4 + slice, smem);
    }
    xcd_barrier(xb);
    phase_dnout(p);
    xcd_barrier(xb);
    {
      EpiMerge<0> E0{(const bf16_t*)(ws + O_PROJ), (bf16_t*)(ws + O_MERGED)};
      pg8::gemm_phase(glds, pg8::Gemm{(const bf16_t*)(ws + O_DNO), (const bf16_t*)(ws + O_WUPA), TS, 1024, 512, 512, 512}, E0);
      EpiMerge<1> E1{(const bf16_t*)(ws + O_PROJ), (bf16_t*)(ws + O_MERGED)};
      pg8::gemm_phase(glds, pg8::Gemm{(const bf16_t*)(ws + O_PROJ) + 2048, (const bf16_t*)(ws + O_WUPB), TS, 1024, 512, 5120, 512}, E1);
    }
    xcd_barrier(xb);
    {
      EpiWout E{slab < 2 ? p.x_prompt + (size_t)tok0 * 1024 : p.x_sample, p.out + (size_t)tok0 * 1024};
      pg8::gemm_phase(glds, pg8::Gemm{(const bf16_t*)(ws + O_MERGED), (const bf16_t*)(ws + O_WOUT), TS, 1024, 1024, 1024, 1024}, E);
    }
    xcd_barrier(xb);
  }

  phase_norm_out(p, p.norm_xa_w);
  xcd_barrier(xb);
  {
    EpiQ E{(bf16_t*)(ws + O_QX)};
    pg8::gemm_phase(glds, pg8::Gemm{HB, (const bf16_t*)(ws + O_WQ), NTOK, 1024, 1024, 1024, 1024}, E);
  }
  xcd_barrier(xb);
#pragma unroll 1
  for (int item = VB(); item < (NTOK / 64) * 4; item += VGRID()) attn_item(p, item, smem);
  xcd_barrier(xb);
  {
    EpiWout E{p.out, p.out};
    pg8::gemm_phase(glds, pg8::Gemm{(const bf16_t*)(ws + O_ATT), (const bf16_t*)(ws + O_WO), NTOK, 1024, 1024, 1024, 1024}, E);
  }
  xcd_barrier(xb);
  phase_norm_out(p, p.norm_ffn_w);
  xcd_barrier(xb);
  {
    EpiGateUp E{(bf16_t*)(ws + O_ACT)};
    pg8::gemm_phase(glds, pg8::Gemm{HB, (const bf16_t*)(ws + O_WGU), NTOK, 5632, 1024, 1024, 1024}, E);
  }
  xcd_barrier(xb);
  {
    EpiWout E{p.out, p.out};
    pg8::gemm_phase(glds, pg8::Gemm{(const bf16_t*)(ws + O_ACT), (const bf16_t*)(ws + O_WDN), NTOK, 1024, 2816, 2816, 2816}, E);
  }
  xcd_barrier(xb);
  phase_final(p);
}

extern "C" void kernel_launch(void* const* d_in, const int* in_sizes, int n_in, void* d_out, int out_size, void* d_ws,
                              size_t ws_size, hipStream_t stream) {
  static int grid_blocks = 0;
  if (!grid_blocks) {
    (void)hipFuncSetAttribute((const void*)fwd_megakernel, hipFuncAttributeMaxDynamicSharedMemorySize, LDS_BYTES + 16);
    int per_cu = 0;
    (void)hipOccupancyMaxActiveBlocksPerMultiprocessor(&per_cu, fwd_megakernel, 512, LDS_BYTES + 16);
    grid_blocks = 256;
    if (per_cu < 1) fprintf(stderr, "occupancy query returned %d\n", per_cu);
  }
  Params p{};
  const float** pp = (const float**)&p;
  for (int i = 0; i < 26; i++) pp[i] = (const float*)d_in[i];
  p.out = (float*)d_out;
  p.ws = (char*)d_ws;
  void* args[] = {&p};
  (void)hipMemsetAsync(d_ws, 0, XCD_BAR_WORDS * 4, stream);
  hipError_t e = hipLaunchCooperativeKernel((void*)fwd_megakernel, dim3(grid_blocks), dim3(512), args, LDS_BYTES + 16, stream);
  if (e != hipSuccess) fprintf(stderr, "cooperative launch failed: %s (grid %d)\n", hipGetErrorString(e), grid_blocks);
}
```

```cpp
#include <hip/hip_runtime.h>
#include <hip/hip_cooperative_groups.h>
#include <cstdio>
namespace cg = cooperative_groups;

typedef unsigned short bf16_t;
typedef __attribute__((ext_vector_type(8))) short bf16x8;
typedef __attribute__((ext_vector_type(4))) float f32x4;
#define DI __device__ __forceinline__
#define MFMA(a, b, c) __builtin_amdgcn_mfma_f32_16x16x32_bf16((a), (b), (c), 0, 0, 0)

constexpr int NTOK = 98304, NPT = 65536, TS = 32768;
constexpr int HALF_LDS = 76032;
constexpr int LDS_BYTES = 2 * HALF_LDS;

constexpr size_t O_BAR = 0;
constexpr size_t O_WIN = 16384;
constexpr size_t O_WUPA = O_WIN + 5376ull * 1024 * 2;
constexpr size_t O_WUPB = O_WUPA + 1024ull * 512 * 2;
constexpr size_t O_WOUT = O_WUPB + 1024ull * 512 * 2;
constexpr size_t O_WQ = O_WOUT + 1024ull * 1024 * 2;
constexpr size_t O_WKV = O_WQ + 1024ull * 1024 * 2;
constexpr size_t O_WO = O_WKV + 2048ull * 1024 * 2;
constexpr size_t O_WGU = O_WO + 1024ull * 1024 * 2;
constexpr size_t O_WDN = O_WGU + 5632ull * 1024 * 2;
constexpr size_t O_SGW = O_WDN + 1024ull * 2816 * 2;
constexpr size_t O_MEMN = O_SGW + 4ull * 128 * 128 * 2;
constexpr size_t O_KB = O_MEMN + 6144ull * 1024 * 2;
constexpr size_t O_VT = O_KB + 6144ull * 1024 * 2;
constexpr size_t O_HB = O_VT + 6144ull * 1024 * 2;
constexpr size_t O_S = O_HB + 98304ull * 1024 * 2;
constexpr size_t O_PROJ = O_S;
constexpr size_t O_AB = O_PROJ + 32768ull * 5120 * 2;
constexpr size_t O_QKV = O_AB + 32768ull * 16 * 4;
constexpr size_t O_LNST = O_QKV + 32768ull * 1536 * 2;
constexpr size_t O_WB = O_LNST + 32768ull * 2 * 4;
constexpr size_t O_UB = O_WB + 2ull * 32768 * 512 * 2;
constexpr size_t O_AI = O_UB + 2ull * 32768 * 512 * 2;
constexpr size_t O_GC = O_AI + 2ull * 32768 * 4 * 64 * 2;
constexpr size_t O_OB = O_GC + 2ull * 32768 * 4 * 4;
constexpr size_t O_MERGED = O_QKV;
constexpr size_t O_DNO = O_AI;
constexpr size_t O_QX = O_S;
constexpr size_t O_ATT = O_S + 98304ull * 1024 * 2;
constexpr size_t O_ACT = O_S;

struct Params {
  const float *x_prompt, *x_sample, *mem_prompt, *mem_sample, *norm_mix_w, *w_in, *conv_w, *a_log, *dt_bias,
      *dn_norm_w, *w_up_a, *sg_ln_w, *sg_ln_b, *sg_w, *sg_b, *w_up_b, *w_out, *norm_xa_w, *norm_mem_w, *xa_w_q,
      *xa_w_kv, *xa_w_o, *norm_ffn_w, *ffn_w_gu, *ffn_w_down, *final_norm_w;
  float* out;
  char* ws;
};

typedef __bf16 hbf16x2 __attribute__((ext_vector_type(2)));
typedef float hf32x2 __attribute__((ext_vector_type(2)));
DI unsigned pack2(float a, float b) { const hf32x2 v = {a, b}; const hbf16x2 h = __builtin_convertvector(v, hbf16x2); return __builtin_bit_cast(unsigned, h); }
DI bf16_t f2bf(float x) { return (bf16_t)(pack2(x, x) & 0xffffu); }
DI float bf2f(bf16_t h) { return __uint_as_float(((unsigned)h) << 16); }
DI float lo2f(unsigned u) { return __uint_as_float(u << 16); }
DI float hi2f(unsigned u) { return __uint_as_float(u & 0xffff0000u); }
DI uint2 pack4(f32x4 v) { return make_uint2(pack2(v[0], v[1]), pack2(v[2], v[3])); }
DI float sigmoidf_(float x) { return __builtin_amdgcn_rcpf(1.f + __expf(-x)); }
DI float siluf_(float x) { return x * sigmoidf_(x); }
DI float geluf_(float x) { float z = 0.7978845608f * (x + 0.044715f * x * x * x); return x * sigmoidf_(2.f * z); }
template <int CTRL> DI float dpp_rot(float v) {
  return __builtin_bit_cast(float, __builtin_amdgcn_mov_dpp(__builtin_bit_cast(int, v), CTRL, 0xF, 0xF, true));
}
DI float sum16(float v) {
  v += dpp_rot<0x128>(v);
  v += dpp_rot<0x124>(v);
  v += dpp_rot<0x122>(v);
  v += dpp_rot<0x121>(v);
  return v;
}
DI float max16(float v) {
  v = fmaxf(v, dpp_rot<0x128>(v));
  v = fmaxf(v, dpp_rot<0x124>(v));
  v = fmaxf(v, dpp_rot<0x122>(v));
  v = fmaxf(v, dpp_rot<0x121>(v));
  return v;
}
DI float wave_sum(float v) {
  v = sum16(v);
  v += __shfl_xor(v, 16);
  v += __shfl_xor(v, 32);
  return v;
}
typedef __attribute__((ext_vector_type(4))) float f32x4_ld;
DI float4 ld_stream(const float* p) { const f32x4_ld t = __builtin_nontemporal_load((const f32x4_ld*)p); return make_float4(t[0], t[1], t[2], t[3]); }
DI const float* xrow(const Params& p, int t) {
  return t < NPT ? p.x_prompt + (size_t)t * 1024 : p.x_sample + (size_t)(t - NPT) * 1024;
}


DI int VB() { return blockIdx.x * 2 + __builtin_amdgcn_readfirstlane(threadIdx.x >> 8); }
DI int VGRID() { return gridDim.x * 2; }
DI int opaque_tid() { int t = threadIdx.x; asm volatile("" : "+v"(t)); return t; }
DI void lds_barrier() { asm volatile("s_waitcnt lgkmcnt(0)" ::: "memory"); __builtin_amdgcn_s_barrier(); asm volatile("" ::: "memory"); }
typedef __attribute__((address_space(1))) char gchar_t;
DI char* opaque_ptr(char* q) { gchar_t* g = (gchar_t*)q; asm volatile("" : "+s"(g)); return (char*)g; }
DI void zero_acc(f32x4 (&acc)[4][4]) {
#pragma unroll
  for (int i = 0; i < 4; i++)
#pragma unroll
    for (int j = 0; j < 4; j++) acc[i][j] = f32x4{0.f, 0.f, 0.f, 0.f};
}

#define LAS __attribute__((address_space(3)))
namespace pg8 {
constexpr int BM = 256, BK = 64, HALF = 128, HTB = HALF * BK * 2, NXCD = 8, WGM = 8;
DI int lds_byte(int r, int c) { const int st = (r >> 4) * 2 + (c >> 5), rr = r & 15, cc = c & 31, ob = rr * 64 + cc * 2; return st * 1024 + (ob ^ (((ob >> 9) & 1) << 5)); }
DI int perm32(int rho) { const int n = rho >> 4, i = rho & 15; return 8 * (i >> 2) + 4 * n + (i & 3); }
DI void stage_rc(int b, int& R, int& C) { const int st = b / 1024, sb = b % 1024, swz = sb ^ (((sb >> 9) & 1) << 5); R = (st >> 1) * 16 + swz / 64; C = (st & 1) * 32 + (swz % 64) / 2; }
struct Unit { int pm, pn; };
struct Gemm { const bf16_t* A; const bf16_t* Bt; int M, N, K, lda, ldb; };
struct StaticOrder {
  int nM, nN, nwg, G, c;
  DI void init(int M, int N, int G_, int c_) { nM = M / BM; nN = N / BM; nwg = nM * nN; G = G_; c = c_; }
  DI bool next(int i, Unit& u) const {
    const long L = (long)i * G + c; if (L >= nwg) return false;
    int wgid = (int)L; { const int q = nwg / NXCD, r = nwg % NXCD, xcd = wgid % NXCD, off = wgid / NXCD; wgid = (xcd < r ? xcd * (q + 1) : r * (q + 1) + (xcd - r) * q) + off; }
    const int nig = WGM * nN, gid = wgid / nig, fm = gid * WGM, gsz = (nM - fm) < WGM ? (nM - fm) : WGM;
    u.pm = fm + ((wgid % nig) % gsz); u.pn = (wgid % nig) / gsz; return true;
  }
};
template <class Epi>
DI void gemm_phase(LAS unsigned char* lds, const Gemm g, const Epi& E, int G_ = -1, int c_ = 0) {
  const int tid = opaque_tid(), wid = __builtin_amdgcn_readfirstlane(tid >> 6), lane = tid & 63, wr = wid >> 2, wc = wid & 3, fr = lane & 15, fq = lane >> 4;
  const int K = g.K, nt = K / BK;
  StaticOrder S; if (G_ > 0) S.init(g.M, g.N, G_, c_); else S.init(g.M, g.N, (int)gridDim.x, (int)blockIdx.x);
  unsigned voffA[2], voffB[2];
#pragma unroll
  for (int i = 0; i < 2; ++i) { int R, C; stage_rc(tid * 16 + i * 8192, R, C);
    const int Rb = Epi::PERM ? ((R & ~31) + perm32(R & 31)) : R;
    voffA[i] = (unsigned)(R * g.lda + C) * 2u; voffB[i] = (unsigned)(Rb * g.ldb + C) * 2u; }
  const size_t kstep = (size_t)(BK * 2);
  const size_t hstepA = (size_t)HALF * g.lda * 2, hstepB = (size_t)HALF * g.ldb * 2;
  const size_t tstepA = 2 * hstepA, tstepB = 2 * hstepB;
  const unsigned ldsw = (unsigned)wid * 1024u;
  const int aoff = lds_byte(wr * 64 + fr, fq * 8), boff = lds_byte(wc * 32 + fr, fq * 8);
#define PG8_SA(b, h) (((b) * 2 + (h)) * HTB)
#define PG8_SB(b, h) ((4 + (b) * 2 + (h)) * HTB)
#define PG8_STAGE(bufoff, gbase, voff) do { _Pragma("unroll") for (int _i = 0; _i < 2; ++_i) \
    __builtin_amdgcn_global_load_lds((const unsigned*)((const char*)(gbase) + (voff)[_i]), (LAS unsigned*)(lds + (bufoff) + ldsw + _i * 8192), 16, 0, 0); } while (0)
#define PG8_LDA(dst, b, h) do { _Pragma("unroll") for (int m = 0; m < 4; ++m) _Pragma("unroll") for (int k = 0; k < 2; ++k) dst[m][k] = *(const LAS bf16x8*)(lds + PG8_SA(b, h) + aoff + m * 2048 + k * 1024); } while (0)
#define PG8_LDB(dst, b, h) do { _Pragma("unroll") for (int n = 0; n < 2; ++n) _Pragma("unroll") for (int k = 0; k < 2; ++k) dst[n][k] = *(const LAS bf16x8*)(lds + PG8_SB(b, h) + boff + n * 2048 + k * 1024); } while (0)
#define PG8_MMA(ai, bj, At, Bt) do { __builtin_amdgcn_s_setprio(1); _Pragma("unroll") for (int m = 0; m < 4; ++m) _Pragma("unroll") for (int n = 0; n < 2; ++n) _Pragma("unroll") for (int k = 0; k < 2; ++k) \
    acc[ai][bj][m][n] = __builtin_amdgcn_mfma_f32_16x16x32_bf16(Bt[n][k], At[m][k], acc[ai][bj][m][n], 0, 0, 0); __builtin_amdgcn_s_setprio(0); } while (0)
#define PG8_WAIT_V(n) asm volatile("s_waitcnt vmcnt(" #n ")" ::: "memory")
#define PG8_WAIT_L(n) asm volatile("s_waitcnt lgkmcnt(" #n ")" ::: "memory")
#define PG8_BAR __builtin_amdgcn_s_barrier()
#define PG8_SCHED __builtin_amdgcn_sched_barrier(0)
  Unit cur, nxt; int ui = 0;
  if (!S.next(0, cur)) return;
  f32x4 acc[2][2][4][2];
#pragma unroll
  for (int a = 0; a < 2; ++a)
#pragma unroll
    for (int b = 0; b < 2; ++b)
#pragma unroll
      for (int m = 0; m < 4; ++m)
#pragma unroll
        for (int n = 0; n < 2; ++n) acc[a][b][m][n] = (f32x4){0.f, 0.f, 0.f, 0.f};
  bf16x8 At[4][2], B0[2][2], B1[2][2];
  const char* cA = (const char*)g.A + (size_t)cur.pm * tstepA; const char* cB = (const char*)g.Bt + (size_t)cur.pn * tstepB;
  PG8_STAGE(PG8_SB(0, 0), cB, voffB); PG8_STAGE(PG8_SA(0, 0), cA, voffA); PG8_STAGE(PG8_SB(0, 1), cB + hstepB, voffB); PG8_STAGE(PG8_SA(0, 1), cA + hstepA, voffA);
  if (wr == 1) PG8_BAR;
  PG8_WAIT_V(4); PG8_BAR;
  PG8_STAGE(PG8_SB(1, 0), cB + kstep, voffB); PG8_STAGE(PG8_SA(1, 0), cA + kstep, voffA); PG8_STAGE(PG8_SB(1, 1), cB + hstepB + kstep, voffB);
  PG8_WAIT_V(6); PG8_BAR;
  for (;;) {
    const bool has_next = S.next(ui + 1, nxt);
    const char* nA = has_next ? (const char*)g.A + (size_t)nxt.pm * tstepA : cA; const char* nB = has_next ? (const char*)g.Bt + (size_t)nxt.pn * tstepB : cB;
    for (int t = 0; t < nt; t += 2) {
      const bool last = (t == nt - 2);
      const char* a1 = cA + (size_t)(t + 1) * kstep;
      const char* a2 = last ? nA : cA + (size_t)(t + 2) * kstep; const char* b2 = last ? nB : cB + (size_t)(t + 2) * kstep;
      const char* a3 = a2 + kstep; const char* b3 = b2 + kstep;
      PG8_LDB(B0, 0, 0); PG8_SCHED; PG8_LDA(At, 0, 0); PG8_STAGE(PG8_SA(1, 1), a1 + hstepA, voffA);
      PG8_WAIT_L(8); PG8_BAR; PG8_WAIT_L(0); PG8_MMA(0, 0, At, B0); PG8_BAR; PG8_SCHED;
      PG8_LDB(B1, 0, 1); PG8_STAGE(PG8_SB(0, 0), b2, voffB);
      PG8_BAR; PG8_WAIT_L(0); PG8_MMA(0, 1, At, B1); PG8_BAR;
      PG8_LDA(At, 0, 1); PG8_STAGE(PG8_SA(0, 0), a2, voffA);
      PG8_BAR; PG8_WAIT_L(0); PG8_MMA(1, 0, At, B0); PG8_BAR; PG8_SCHED;
      PG8_STAGE(PG8_SB(0, 1), b2 + hstepB, voffB);
      PG8_WAIT_V(6); PG8_BAR; PG8_MMA(1, 1, At, B1); PG8_BAR;
      PG8_LDB(B0, 1, 0); PG8_SCHED; PG8_LDA(At, 1, 0); PG8_STAGE(PG8_SA(0, 1), a2 + hstepA, voffA);
      PG8_WAIT_L(8); PG8_BAR; PG8_WAIT_L(0); PG8_MMA(0, 0, At, B0); PG8_BAR; PG8_SCHED;
      PG8_LDB(B1, 1, 1); PG8_STAGE(PG8_SB(1, 0), b3, voffB);
      PG8_BAR; PG8_WAIT_L(0); PG8_MMA(0, 1, At, B1); PG8_BAR;
      PG8_LDA(At, 1, 1); PG8_STAGE(PG8_SA(1, 0), a3, voffA);
      PG8_BAR; PG8_WAIT_L(0); PG8_MMA(1, 0, At, B0); PG8_BAR; PG8_SCHED;
      PG8_STAGE(PG8_SB(1, 1), b3 + hstepB, voffB);
      PG8_WAIT_V(6); PG8_BAR; PG8_MMA(1, 1, At, B1); PG8_BAR;
    }
    E(acc, cur, wr, wc, fr, fq);
    if (!has_next) break;
#pragma unroll
    for (int a = 0; a < 2; ++a)
#pragma unroll
      for (int b = 0; b < 2; ++b)
#pragma unroll
        for (int m = 0; m < 4; ++m)
#pragma unroll
          for (int n = 0; n < 2; ++n) acc[a][b][m][n] = (f32x4){0.f, 0.f, 0.f, 0.f};
    cur = nxt; cA = nA; cB = nB; ++ui;
  }
  PG8_WAIT_V(0);
  if (wr == 0) PG8_BAR;
  PG8_BAR;
#undef PG8_SA
#undef PG8_SB
#undef PG8_STAGE
#undef PG8_LDA
#undef PG8_LDB
#undef PG8_MMA
#undef PG8_WAIT_V
#undef PG8_WAIT_L
#undef PG8_BAR
#undef PG8_SCHED
}
}

#define XB_TMO      128
#define XB_XCNT(j)  (256  + 64 * (j))
#define XB_XSUB(j)  (1280 + 64 * (j))
#define XB_XGEN(j)  (2304 + 64 * (j))
#define XB_TOP      3328
#define XB_TOPGEN   3392
#define XCD_BAR_WORDS 3456
#define XB_SPIN_CAP (1u << 18)
DI unsigned xb_ld(unsigned* p) { return __hip_atomic_load(p, __ATOMIC_RELAXED, __HIP_MEMORY_SCOPE_AGENT); }
DI unsigned xb_add(unsigned* p, unsigned v) { return __hip_atomic_fetch_add(p, v, __ATOMIC_RELAXED, __HIP_MEMORY_SCOPE_AGENT); }
DI unsigned xb_xcc_id() { return (unsigned)__builtin_amdgcn_s_getreg((3 << 11) | 20) & 0xFu; }
#define XB_SPIN(cond, bar) do { unsigned _sp = 0; while (cond) { __builtin_amdgcn_s_sleep(1); \
    if ((++_sp & 255u) == 0u) { if (xb_ld(&(bar)[XB_TMO])) break; if (_sp > XB_SPIN_CAP) { atomicAdd(&(bar)[XB_TMO], 1u); break; } } } } while (0)
struct XcdBarrier { unsigned* bar; unsigned x; volatile LAS unsigned* st; };
DI XcdBarrier xcd_barrier_post(unsigned* bar, volatile LAS unsigned* st) {
  XcdBarrier b; b.bar = bar; b.x = xb_xcc_id(); b.st = st;
  if (threadIdx.x == 0) (void)xb_add(&bar[XB_XCNT(b.x)], 1u);
  return b;
}
DI void xcd_barrier_complete(unsigned* bar, unsigned x, unsigned& nloc, unsigned& nx) {
  const unsigned G = gridDim.x * gridDim.y * gridDim.z;
  unsigned sum, cnt, mine, sp = 0u;
  for (;;) {
    sum = 0u; cnt = 0u; mine = 0u;
#pragma unroll
    for (unsigned j = 0; j < 16; ++j) { const unsigned c = xb_ld(&bar[XB_XCNT(j)]); sum += c; cnt += (c > 0u) ? 1u : 0u; mine = (j == x) ? c : mine; }
    if (sum == G) break;
    __builtin_amdgcn_s_sleep(1);
    if ((++sp & 255u) == 0u) { if (xb_ld(&bar[XB_TMO])) break; if (sp > XB_SPIN_CAP) { atomicAdd(&bar[XB_TMO], 1u); break; } }
  }
  nloc = mine > 0u ? mine : 1u; nx = cnt > 0u ? cnt : 1u;
}
DI void xcd_barrier(const XcdBarrier& b) {
  asm volatile("s_waitcnt vmcnt(0)" ::: "memory");
  __syncthreads();
  if (threadIdx.x == 0) {
    unsigned* bar = b.bar;
    __builtin_amdgcn_s_waitcnt(0);
    unsigned nloc = b.st[0], nx = b.st[1];
    if (nloc == 0u) { xcd_barrier_complete(bar, b.x, nloc, nx); b.st[0] = nloc; b.st[1] = nx; }
    const unsigned old = xb_add(&bar[XB_XSUB(b.x)], 1u);
    const unsigned gen = old / nloc;
    if (old + 1u == (gen + 1u) * nloc) {
      __builtin_amdgcn_fence(__ATOMIC_RELEASE, "agent");
      asm volatile("s_waitcnt vmcnt(0)" ::: "memory");
      const unsigned og = xb_add(&bar[XB_TOP], 1u);
      const unsigned tg = og / nx;
      if (og + 1u == (tg + 1u) * nx) xb_add(&bar[XB_TOPGEN], 1u);
      else XB_SPIN(xb_ld(&bar[XB_TOPGEN]) == tg, bar);
      __builtin_amdgcn_fence(__ATOMIC_ACQUIRE, "agent");
      xb_add(&bar[XB_XGEN(b.x)], 1u);
      asm volatile("s_waitcnt vmcnt(0)" ::: "memory");
    } else {
      XB_SPIN(xb_ld(&bar[XB_XGEN(b.x)]) == gen, bar);
      __builtin_amdgcn_fence(__ATOMIC_ACQUIRE, "agent");
      asm volatile("s_waitcnt vmcnt(0)" ::: "memory");
    }
  }
  __syncthreads();
}

typedef __attribute__((ext_vector_type(4))) short s16x4;
#define TR8(base, o0, o1, o2, o3, o4, o5, o6, o7, r0, r1, r2, r3, r4, r5, r6, r7)                                    \
  asm volatile("ds_read_b64_tr_b16 %0, %8 offset:%9\n\tds_read_b64_tr_b16 %1, %8 offset:%10\n\t"                      \
               "ds_read_b64_tr_b16 %2, %8 offset:%11\n\tds_read_b64_tr_b16 %3, %8 offset:%12\n\t"                     \
               "ds_read_b64_tr_b16 %4, %8 offset:%13\n\tds_read_b64_tr_b16 %5, %8 offset:%14\n\t"                     \
               "ds_read_b64_tr_b16 %6, %8 offset:%15\n\tds_read_b64_tr_b16 %7, %8 offset:%16\n\ts_waitcnt lgkmcnt(0)" \
               : "=&v"(r0), "=&v"(r1), "=&v"(r2), "=&v"(r3), "=&v"(r4), "=&v"(r5), "=&v"(r6), "=&v"(r7)               \
               : "v"(base), "n"(o0), "n"(o1), "n"(o2), "n"(o3), "n"(o4), "n"(o5), "n"(o6), "n"(o7)                    \
               : "memory")
DI bf16x8 cat8(s16x4 lo, s16x4 hi) { return __builtin_shufflevector(lo, hi, 0, 1, 2, 3, 4, 5, 6, 7); }

typedef f32x4 Acc8[2][2][4][2];
#define EPI_FOR                                   \
  _Pragma("unroll") for (int ai = 0; ai < 2; ++ai) \
  _Pragma("unroll") for (int m = 0; m < 4; ++m)    \
  _Pragma("unroll") for (int bj = 0; bj < 2; ++bj) \
  _Pragma("unroll") for (int n = 0; n < 2; ++n)
#define EPI_ROW (u.pm * 256 + ai * 128 + wr * 64 + m * 16 + fr)
#define EPI_COL (u.pn * 256 + bj * 128 + wc * 32 + n * 16 + fq * 4)

#define TILE_VARS                                                                                      \
  const int tid = opaque_tid() & 255, lane = tid & 63, w = tid >> 6, wr = w >> 1, wc = w & 1, fr = lane & 15, \
            fq = lane >> 4;                                                                            \
  (void)tid; (void)lane; (void)w; (void)wr; (void)wc; (void)fr; (void)fq;

DI int map_col(int mode, int n) {
  if (mode == 0) return n;
  if (mode == 1) {
    if (n < 1536) return n;
    if (n < 5120) return n + 16;
    if (n < 5136) return 1536 + (n - 5120);
    return -1;
  }
  int q = n >> 8, s = n & 255;
  return s < 128 ? q * 128 + s : 2816 + q * 128 + (s - 128);
}
DI void transpose_weight(const float* __restrict__ src, int K, int Nsrc, bf16_t* __restrict__ dst, int Ndst, int mode,
                         char* smem, int vb = -1, int vgrid = 0) {
  if (vb < 0) { vb = VB(); vgrid = VGRID(); }
  float* tile = (float*)smem;
  const int tid = opaque_tid() & 255;
  const int nkt = K >> 6, nnt = Ndst >> 6, ntile = nkt * nnt;
  for (int t = vb; t < ntile; t += vgrid) {
    const int kt = t / nnt, nt = t % nnt;
    {
      const int nn = tid & 63, kk0 = tid >> 6;
      const int sc = map_col(mode, nt * 64 + nn);
#pragma unroll
      for (int i = 0; i < 16; i++) {
        const int kk = kk0 + i * 4;
        tile[kk * 65 + nn] = sc >= 0 ? src[(size_t)(kt * 64 + kk) * Nsrc + sc] : 0.f;
      }
    }
    __syncthreads();
    {
      const int kk = (tid & 31) * 2, nn0 = tid >> 5;
#pragma unroll
      for (int i = 0; i < 8; i++) {
        const int nn = nn0 + i * 8;
        *(unsigned*)(dst + (size_t)(nt * 64 + nn) * K + kt * 64 + kk) = pack2(tile[kk * 65 + nn], tile[(kk + 1) * 65 + nn]);
      }
    }
    __syncthreads();
  }
}

template <class SrcFn>
DI void rownorm4_bf16(SrcFn srcfn, int t0, const float* __restrict__ wgt, bf16_t* __restrict__ dst0, int lane) {
  float4 v[4][4];
#pragma unroll
  for (int r = 0; r < 4; r++) {
    const float* src = srcfn(t0 + r);
#pragma unroll
    for (int i = 0; i < 4; i++) v[r][i] = ld_stream(src + (lane + i * 64) * 4);
  }
  float4 ww[4];
#pragma unroll
  for (int i = 0; i < 4; i++) ww[i] = ((const float4*)wgt)[lane + i * 64];
#pragma unroll
  for (int r = 0; r < 4; r++) {
    float ss = 0.f;
#pragma unroll
    for (int i = 0; i < 4; i++) ss += v[r][i].x * v[r][i].x + v[r][i].y * v[r][i].y + v[r][i].z * v[r][i].z + v[r][i].w * v[r][i].w;
    ss = wave_sum(ss);
    const float rs = rsqrtf(ss * (1.f / 1024.f) + 1e-6f);
#pragma unroll
    for (int i = 0; i < 4; i++)
      ((uint2*)(dst0 + (size_t)r * 1024))[lane + i * 64] =
          make_uint2(pack2(v[r][i].x * rs * ww[i].x, v[r][i].y * rs * ww[i].y), pack2(v[r][i].z * rs * ww[i].z, v[r][i].w * rs * ww[i].w));
  }
}

DI void prep_item(const Params& p, int L, int nseq, int nch, int item, char* smem) {
  TILE_VARS
  char* const wsb = opaque_ptr(p.ws);
  bf16_t* Ks = (bf16_t*)smem;
  bf16_t* Qs = (bf16_t*)(smem + 17408);
  bf16_t* Vs = (bf16_t*)(smem + 34816);
  bf16_t* K2 = (bf16_t*)(smem + 53248);
  float* sGc = (float*)(smem + 71680);
  float* sBeta = sGc + 64;
  float* Ls = (float*)Qs;
  bf16_t* Ts = Ks;
  const bf16_t* QKV = (const bf16_t*)(wsb + O_QKV);
  const float* AB = (const float*)(wsb + O_AB);
  bf16_t* WB = (bf16_t*)(wsb + O_WB);
  bf16_t* UB = (bf16_t*)(wsb + O_UB);
  bf16_t* AI = (bf16_t*)(wsb + O_AI);
  float* GC = (float*)(wsb + O_GC);

  const int np = item % nch;
  int tmp = item / nch;
  const int h = tmp & 3;
  tmp >>= 2;
  const int seqi = tmp % nseq, dir = tmp / nseq;
  const int n = dir ? nch - 1 - np : np;
  const int tb = seqi * L + n * 64;

  uint4 kq0, kq1, kq2, kq3, kk[4], kv[4];
  {
    const int r4 = tid >> 4, kc = tid & 15;
    const bf16_t* base = QKV + h * 128 + kc * 8;
    const size_t o0 = (size_t)(tb + (dir ? 63 - r4 : r4)) * 1536, o1 = (size_t)(tb + (dir ? 47 - r4 : r4 + 16)) * 1536;
    const size_t o2 = (size_t)(tb + (dir ? 31 - r4 : r4 + 32)) * 1536, o3 = (size_t)(tb + (dir ? 15 - r4 : r4 + 48)) * 1536;
    kq0 = *(const uint4*)(base + o0); kq1 = *(const uint4*)(base + o1); kq2 = *(const uint4*)(base + o2); kq3 = *(const uint4*)(base + o3);
    kk[0] = *(const uint4*)(base + o0 + 512); kk[1] = *(const uint4*)(base + o1 + 512);
    kk[2] = *(const uint4*)(base + o2 + 512); kk[3] = *(const uint4*)(base + o3 + 512);
    kv[0] = *(const uint4*)(base + o0 + 1024); kv[1] = *(const uint4*)(base + o1 + 1024);
    kv[2] = *(const uint4*)(base + o2 + 1024); kv[3] = *(const uint4*)(base + o3 + 1024);
  }
  if (w == 0) {
    const int tl = tb + (dir ? 63 - lane : lane);
    const float* ab = AB + (size_t)tl * 16;
    const float bet = sigmoidf_(ab[dir * 4 + h]);
    const float xx = ab[8 + dir * 4 + h] + p.dt_bias[dir * 4 + h];
    const float ex = __expf(xx);
    const float sp = xx > 20.f ? xx : (ex < 0.03125f ? ex * (1.f - ex * (0.5f - ex * (0.33333334f - 0.25f * ex))) : __logf(1.f + ex));
    float gv = -__expf(p.a_log[dir * 4 + h]) * sp;
#pragma unroll
    for (int o = 1; o < 64; o <<= 1) {
      const float t = __shfl_up(gv, o);
      if (lane >= o) gv += t;
    }
    sGc[lane] = gv;
    sBeta[lane] = bet;
    GC[(size_t)item * 64 + lane] = gv;
  }
  {
    const int r4 = tid >> 4, kc = tid & 15;
    *(uint4*)(Qs + r4 * 136 + kc * 8) = kq0;
    *(uint4*)(Qs + (r4 + 16) * 136 + kc * 8) = kq1;
    *(uint4*)(Qs + (r4 + 32) * 136 + kc * 8) = kq2;
    *(uint4*)(Qs + (r4 + 48) * 136 + kc * 8) = kq3;
#pragma unroll
    for (int i = 0; i < 4; i++) *(uint4*)(Ks + (r4 + 16 * i) * 136 + kc * 8) = make_uint4(kk[i].x, kk[i].y, kk[i].z, kk[i].w);
  }
  lds_barrier();
#pragma unroll
  for (int i = 0; i < 4; i++) {
    const int id = tid + i * 256, s = id >> 4, kc = id & 15;
    const float b = sBeta[s];
    const float sk = b * __expf(sGc[s]);
    uint4 vo, ko;
    vo.x = pack2(lo2f(kv[i].x) * b, hi2f(kv[i].x) * b); vo.y = pack2(lo2f(kv[i].y) * b, hi2f(kv[i].y) * b);
    vo.z = pack2(lo2f(kv[i].z) * b, hi2f(kv[i].z) * b); vo.w = pack2(lo2f(kv[i].w) * b, hi2f(kv[i].w) * b);
    ko.x = pack2(lo2f(kk[i].x) * sk, hi2f(kk[i].x) * sk); ko.y = pack2(lo2f(kk[i].y) * sk, hi2f(kk[i].y) * sk);
    ko.z = pack2(lo2f(kk[i].z) * sk, hi2f(kk[i].z) * sk); ko.w = pack2(lo2f(kk[i].w) * sk, hi2f(kk[i].w) * sk);
    *(uint4*)(Vs + s * 144 + kc * 8) = vo;
    *(uint4*)(K2 + s * 144 + kc * 8) = ko;
  }
  f32x4 accG[4], accA[4];
#pragma unroll
  for (int j = 0; j < 4; j++) { accG[j] = f32x4{0, 0, 0, 0}; accA[j] = f32x4{0, 0, 0, 0}; }
#pragma unroll
  for (int ks = 0; ks < 4; ks++) {
    const bf16x8 ak = *(const bf16x8*)(Ks + (w * 16 + fr) * 136 + ks * 32 + fq * 8);
    const bf16x8 aq = *(const bf16x8*)(Qs + (w * 16 + fr) * 136 + ks * 32 + fq * 8);
#pragma unroll
    for (int j = 0; j < 4; j++) {
      const bf16x8 b = *(const bf16x8*)(Ks + (j * 16 + fr) * 136 + ks * 32 + fq * 8);
      accG[j] = MFMA(ak, b, accG[j]);
      accA[j] = MFMA(aq, b, accA[j]);
    }
  }
  lds_barrier();
#pragma unroll
  for (int j = 0; j < 4; j++) {
    const int s = j * 16 + fr;
    const float gs = sGc[s];
#pragma unroll
    for (int r = 0; r < 4; r++) {
      const int c = w * 16 + fq * 4 + r;
      const float dec = __expf(fminf(sGc[c] - gs, 0.f));
      Ls[c * 68 + s] = (s < c) ? sBeta[c] * accG[j][r] * dec : 0.f;
      AI[(size_t)item * 4096 + c * 64 + s] = f2bf((s <= c) ? accA[j][r] * dec : 0.f);
    }
  }
  lds_barrier();
  if (w == 0) {
    typedef float f32x2_t __attribute__((ext_vector_type(2)));
    f32x2_t tp[32];
#pragma unroll
    for (int i = 0; i < 64; i++) {
      f32x2_t a0 = {(i == lane) ? 1.f : 0.f, 0.f}, a1 = {0.f, 0.f};
#pragma unroll
      for (int jp = 0; jp < i / 2; jp++) {
        const f32x2_t lv = *(const f32x2_t*)(Ls + i * 68 + 2 * jp);
        if (jp & 1) a1 -= lv * tp[jp]; else a0 -= lv * tp[jp];
      }
      float ti = (a0[0] + a0[1]) + (a1[0] + a1[1]);
      if (i & 1) ti -= Ls[i * 68 + i - 1] * tp[(i - 1) >> 1][0];
      if (i & 1) tp[i >> 1][1] = ti; else tp[i >> 1][0] = ti;
      Ts[i * 72 + lane] = f2bf(ti);
    }
  }
  lds_barrier();
  f32x4 accU[8], accW[8];
#pragma unroll
  for (int j = 0; j < 8; j++) { accU[j] = f32x4{0, 0, 0, 0}; accW[j] = f32x4{0, 0, 0, 0}; }
  {
    const unsigned off = (unsigned)((fq * 8 + (fr >> 2)) * 288 + (fr & 3) * 8);
    const unsigned vb0 = (unsigned)(size_t)Vs + off, kb0 = (unsigned)(size_t)K2 + off;
#pragma unroll
    for (int ks = 0; ks < 2; ks++) {
      const bf16x8 a = *(const bf16x8*)(Ts + (w * 16 + fr) * 72 + ks * 32 + fq * 8);
      s16x4 l0, l1, l2, l3, l4, l5, l6, l7, h0, h1, h2, h3, h4, h5, h6, h7;
      if (ks == 0) {
        TR8(vb0, 0, 32, 64, 96, 128, 160, 192, 224, l0, l1, l2, l3, l4, l5, l6, l7);
        TR8(vb0, 1152, 1184, 1216, 1248, 1280, 1312, 1344, 1376, h0, h1, h2, h3, h4, h5, h6, h7);
      } else {
        TR8(vb0, 9216, 9248, 9280, 9312, 9344, 9376, 9408, 9440, l0, l1, l2, l3, l4, l5, l6, l7);
        TR8(vb0, 10368, 10400, 10432, 10464, 10496, 10528, 10560, 10592, h0, h1, h2, h3, h4, h5, h6, h7);
      }
      accU[0] = MFMA(cat8(l0, h0), a, accU[0]); accU[1] = MFMA(cat8(l1, h1), a, accU[1]);
      accU[2] = MFMA(cat8(l2, h2), a, accU[2]); accU[3] = MFMA(cat8(l3, h3), a, accU[3]);
      accU[4] = MFMA(cat8(l4, h4), a, accU[4]); accU[5] = MFMA(cat8(l5, h5), a, accU[5]);
      accU[6] = MFMA(cat8(l6, h6), a, accU[6]); accU[7] = MFMA(cat8(l7, h7), a, accU[7]);
      if (ks == 0) {
        TR8(kb0, 0, 32, 64, 96, 128, 160, 192, 224, l0, l1, l2, l3, l4, l5, l6, l7);
        TR8(kb0, 1152, 1184, 1216, 1248, 1280, 1312, 1344, 1376, h0, h1, h2, h3, h4, h5, h6, h7);
      } else {
        TR8(kb0, 9216, 9248, 9280, 9312, 9344, 9376, 9408, 9440, l0, l1, l2, l3, l4, l5, l6, l7);
        TR8(kb0, 10368, 10400, 10432, 10464, 10496, 10528, 10560, 10592, h0, h1, h2, h3, h4, h5, h6, h7);
      }
      accW[0] = MFMA(cat8(l0, h0), a, accW[0]); accW[1] = MFMA(cat8(l1, h1), a, accW[1]);
      accW[2] = MFMA(cat8(l2, h2), a, accW[2]); accW[3] = MFMA(cat8(l3, h3), a, accW[3]);
      accW[4] = MFMA(cat8(l4, h4), a, accW[4]); accW[5] = MFMA(cat8(l5, h5), a, accW[5]);
      accW[6] = MFMA(cat8(l6, h6), a, accW[6]); accW[7] = MFMA(cat8(l7, h7), a, accW[7]);
    }
  }
  {
    bf16_t* up = UB + (size_t)item * 8192 + (w * 16 + fr) * 128 + fq * 4;
    bf16_t* wp = WB + (size_t)item * 8192 + (w * 16 + fr) * 128 + fq * 4;
#pragma unroll
    for (int j = 0; j < 8; j++) {
      *(uint2*)(up + j * 16) = pack4(accU[j]);
      *(uint2*)(wp + j * 16) = pack4(accW[j]);
    }
  }
  lds_barrier();
}

DI void sgmix_item(const Params& p, int item, char* smem) {
  TILE_VARS
  char* const wsb = opaque_ptr(p.ws);
  bf16_t* As = (bf16_t*)smem;
  bf16_t* Bs = (bf16_t*)(smem + 34816);
  bf16_t* PROJ = (bf16_t*)(wsb + O_PROJ);
  const float* LNST = (const float*)(wsb + O_LNST);
  const bf16_t* SGW = (const bf16_t*)(wsb + O_SGW);
  const int g = item & 3, cb = item >> 2;
  const int t0 = cb * 128;
#pragma unroll
  for (int i = 0; i < 8; i++) {
    const int id = tid + i * 256, row = id >> 4, cc = id & 15;
    *(uint4*)(As + row * 136 + cc * 8) = *(const uint4*)(SGW + (size_t)g * 16384 + row * 128 + cc * 8);
    const uint4 v = *(const uint4*)(PROJ + (size_t)(t0 + row) * 5120 + 2560 + g * 128 + cc * 8);
    const float mu = LNST[(size_t)(t0 + row) * 2], rstd = LNST[(size_t)(t0 + row) * 2 + 1];
    const unsigned vv[4] = {v.x, v.y, v.z, v.w};
#pragma unroll
    for (int e = 0; e < 4; e++) {
      const int c0 = cc * 8 + 2 * e;
      const float w0 = p.sg_ln_w[g * 128 + c0], w1 = p.sg_ln_w[g * 128 + c0 + 1];
      const float b0 = p.sg_ln_b[g * 128 + c0], b1 = p.sg_ln_b[g * 128 + c0 + 1];
      Bs[c0 * 136 + row] = f2bf((geluf_(lo2f(vv[e])) - mu) * rstd * w0 + b0);
      Bs[(c0 + 1) * 136 + row] = f2bf((geluf_(hi2f(vv[e])) - mu) * rstd * w1 + b1);
    }
  }
  lds_barrier();
  f32x4 acc[4][4];
  zero_acc(acc);
#pragma unroll
  for (int ks = 0; ks < 4; ks++) {
    bf16x8 af[4], bfr[4];
#pragma unroll
    for (int i = 0; i < 4; i++) af[i] = *(const bf16x8*)(As + (wr * 64 + i * 16 + fr) * 136 + ks * 32 + fq * 8);
#pragma unroll
    for (int j = 0; j < 4; j++) bfr[j] = *(const bf16x8*)(Bs + (wc * 64 + j * 16 + fr) * 136 + ks * 32 + fq * 8);
#pragma unroll
    for (int i = 0; i < 4; i++)
#pragma unroll
      for (int j = 0; j < 4; j++) acc[i][j] = MFMA(bfr[j], af[i], acc[i][j]);
  }
  {
    uint2 ur[4][4];
#pragma unroll
    for (int i = 0; i < 4; i++)
#pragma unroll
      for (int j = 0; j < 4; j++)
        ur[i][j] = *(const uint2*)(PROJ + (size_t)(t0 + wr * 64 + i * 16 + fr) * 5120 + 2048 + g * 128 + wc * 64 + j * 16 + fq * 4);
    asm volatile("" ::: "memory");
#pragma unroll
    for (int i = 0; i < 4; i++) {
      const int t = wr * 64 + i * 16 + fr;
      const float bias = p.sg_b[g * 128 + t];
#pragma unroll
      for (int j = 0; j < 4; j++) {
        const int c = wc * 64 + j * 16 + fq * 4;
        const uint2 u = ur[i][j];
        f32x4 o;
        o[0] = geluf_(lo2f(u.x)) * (acc[i][j][0] + bias);
        o[1] = geluf_(hi2f(u.x)) * (acc[i][j][1] + bias);
        o[2] = geluf_(lo2f(u.y)) * (acc[i][j][2] + bias);
        o[3] = geluf_(hi2f(u.y)) * (acc[i][j][3] + bias);
        *(uint2*)(PROJ + (size_t)(t0 + t) * 5120 + 2048 + g * 128 + c) = pack4(o);
      }
    }
  }
  lds_barrier();
}

#define KV_LOAD(SRC)                                                                           \
  kr0 = *(const uint4*)((SRC) + (size_t)(tid >> 5) * 256 + (tid & 31) * 8);                    \
  kr1 = *(const uint4*)((SRC) + (size_t)((tid >> 5) + 8) * 256 + (tid & 31) * 8);              \
  kr2 = *(const uint4*)((SRC) + (size_t)((tid >> 5) + 16) * 256 + (tid & 31) * 8);             \
  kr3 = *(const uint4*)((SRC) + (size_t)((tid >> 5) + 24) * 256 + (tid & 31) * 8);             \
  kr4 = *(const uint4*)((SRC) + (size_t)((tid >> 5) + 32) * 256 + (tid & 31) * 8);             \
  kr5 = *(const uint4*)((SRC) + (size_t)((tid >> 5) + 40) * 256 + (tid & 31) * 8);             \
  kr6 = *(const uint4*)((SRC) + (size_t)((tid >> 5) + 48) * 256 + (tid & 31) * 8);             \
  kr7 = *(const uint4*)((SRC) + (size_t)((tid >> 5) + 56) * 256 + (tid & 31) * 8);
#define KV_STORE()                                                                             \
  *(uint4*)(KVs + ((tid >> 5)) * 264 + (tid & 31) * 8) = kr0;                                  \
  *(uint4*)(KVs + ((tid >> 5) + 8) * 264 + (tid & 31) * 8) = kr1;                              \
  *(uint4*)(KVs + ((tid >> 5) + 16) * 264 + (tid & 31) * 8) = kr2;                             \
  *(uint4*)(KVs + ((tid >> 5) + 24) * 264 + (tid & 31) * 8) = kr3;                             \
  *(uint4*)(KVs + ((tid >> 5) + 32) * 264 + (tid & 31) * 8) = kr4;                             \
  *(uint4*)(KVs + ((tid >> 5) + 40) * 264 + (tid & 31) * 8) = kr5;                             \
  *(uint4*)(KVs + ((tid >> 5) + 48) * 264 + (tid & 31) * 8) = kr6;                             \
  *(uint4*)(KVs + ((tid >> 5) + 56) * 264 + (tid & 31) * 8) = kr7;
DI void attn_item(const Params& p, int item, char* smem) {
  TILE_VARS
  char* const wsb = opaque_ptr(p.ws);
  bf16_t* Qs = (bf16_t*)smem;
  bf16_t* KVs = (bf16_t*)(smem + 33792);
  float* sL = (float*)(smem + 67584);
  bf16_t* Ps = Qs;
  const bf16_t* QX = (const bf16_t*)(wsb + O_QX);
  const bf16_t* KB = (const bf16_t*)(wsb + O_KB);
  const bf16_t* VT = (const bf16_t*)(wsb + O_VT);
  bf16_t* ATT = (bf16_t*)(wsb + O_ATT);
  const int head = item & 3, qt = item >> 2;
  const int t0 = qt * 64;
  const int b = t0 < NPT ? t0 / 8192 : 8 + (t0 - NPT) / 2048;
  const bf16_t* Kp = KB + ((size_t)(b * 4 + head)) * 65536;
  const bf16_t* Vp = VT + ((size_t)(b * 4 + head)) * 65536;
  uint4 kr0, kr1, kr2, kr3, kr4, kr5, kr6, kr7;
  KV_LOAD(Kp)
#pragma unroll
  for (int i = 0; i < 8; i++) {
    const int id = tid + i * 256, row = id >> 5, cc = id & 31;
    *(uint4*)(Qs + row * 264 + cc * 8) = *(const uint4*)(QX + (size_t)(t0 + row) * 1024 + head * 256 + cc * 8);
  }
  f32x4 sc[16];
#pragma unroll
  for (int t = 0; t < 16; t++) sc[t] = f32x4{0, 0, 0, 0};
#pragma unroll
  for (int kc = 0; kc < 4; kc++) {
    lds_barrier();
    KV_STORE()
    if (kc < 3) { KV_LOAD(Kp + (size_t)(kc + 1) * 64 * 256) } else { KV_LOAD(Vp) }
    lds_barrier();
#pragma unroll
    for (int ks = 0; ks < 8; ks++) {
      const bf16x8 a = *(const bf16x8*)(Qs + (w * 16 + fr) * 264 + ks * 32 + fq * 8);
#pragma unroll
      for (int j = 0; j < 4; j++) {
        const bf16x8 bb = *(const bf16x8*)(KVs + (j * 16 + fr) * 264 + ks * 32 + fq * 8);
        sc[kc * 4 + j] = MFMA(a, bb, sc[kc * 4 + j]);
      }
    }
  }
  float lsum[4];
#pragma unroll
  for (int r = 0; r < 4; r++) {
    float m = sc[0][r];
#pragma unroll
    for (int t = 1; t < 16; t++) m = fmaxf(m, sc[t][r]);
    m = max16(m);
    float sm = 0.f;
#pragma unroll
    for (int t = 0; t < 16; t++) {
      const float e = __expf(sc[t][r] - m);
      sc[t][r] = e;
      sm += e;
    }
    lsum[r] = sum16(sm);
  }
  lds_barrier();
  if (fr == 0) {
#pragma unroll
    for (int r = 0; r < 4; r++) sL[w * 16 + fq * 4 + r] = lsum[r];
  }
#pragma unroll
  for (int t = 0; t < 16; t++)
#pragma unroll
    for (int r = 0; r < 4; r++) Ps[(w * 16 + fq * 4 + r) * 264 + t * 16 + fr] = f2bf(sc[t][r]);
#pragma unroll
  for (int dc = 0; dc < 4; dc++) {
    if (dc > 0) lds_barrier();
    KV_STORE()
    if (dc < 3) { KV_LOAD(Vp + (size_t)(dc + 1) * 64 * 256) }
    lds_barrier();
    f32x4 o[4];
#pragma unroll
    for (int j = 0; j < 4; j++) o[j] = f32x4{0, 0, 0, 0};
#pragma unroll
    for (int ks = 0; ks < 8; ks++) {
      const bf16x8 pa = *(const bf16x8*)(Ps + (w * 16 + fr) * 264 + ks * 32 + fq * 8);
#pragma unroll
      for (int j = 0; j < 4; j++) {
        const bf16x8 bb = *(const bf16x8*)(KVs + (j * 16 + fr) * 264 + ks * 32 + fq * 8);
        o[j] = MFMA(bb, pa, o[j]);
      }
    }
    const float linv = 1.f / sL[w * 16 + fr];
#pragma unroll
    for (int j = 0; j < 4; j++) {
      f32x4 v = o[j];
#pragma unroll
      for (int r = 0; r < 4; r++) v[r] *= linv;
      *(uint2*)(ATT + (size_t)(t0 + w * 16 + fr) * 1024 + head * 256 + dc * 64 + j * 16 + fq * 4) = pack4(v);
    }
  }
  lds_barrier();
}
#undef KV_LOAD
#undef KV_STORE

DI void scan_pair16(const Params& p, int L, int nseq, int nch, int chain, int pair, char* lds) {
  TILE_VARS
  const int t5 = opaque_tid();
  const int half = __builtin_amdgcn_readfirstlane(t5 >> 8);
  char* const wsb = opaque_ptr(p.ws);
  char* const own = lds + half * HALF_LDS;
  bf16_t* St = (bf16_t*)own;
  bf16_t* Vnt = (bf16_t*)(own + 8704);
  bf16_t* Vnk = (bf16_t*)(own + 11008);
  bf16_t* Ws = (bf16_t*)(lds + 13312);
  bf16_t* Qs = (bf16_t*)(lds + 30720);
  bf16_t* As = (bf16_t*)(lds + 48128);
  bf16_t* Ks = (bf16_t*)(lds + 57344);
  const bf16_t* QKV = (const bf16_t*)(wsb + O_QKV);
  const bf16_t* WB = (const bf16_t*)(wsb + O_WB);
  const bf16_t* UB = (const bf16_t*)(wsb + O_UB);
  const bf16_t* AI = (const bf16_t*)(wsb + O_AI);
  const float* GC = (const float*)(wsb + O_GC);
  bf16_t* OB = (bf16_t*)(wsb + O_OB);
  const int h = chain & 3;
  const int seqi = (chain >> 2) % nseq, dir = (chain >> 2) / nseq;
  const size_t idx0 = (size_t)chain * nch;
  const int ecol0 = h * 128 + (2 * pair + half) * 16;
  const int r5 = t5 >> 4, c4 = (t5 & 15) * 8;
  const int r6 = t5 >> 3, c3 = (t5 & 7) * 8;

  for (int i = tid; i < 2 * 16 * 136 / 2; i += 256) ((unsigned*)St)[i] = 0u;
  f32x4 accS[2];
  accS[0] = f32x4{0, 0, 0, 0};
  accS[1] = f32x4{0, 0, 0, 0};

  uint4 pw0, pw1, pq0, pq1, pk0, pk1, pa0;
  float pgl, pge;
  float4 pgv;
  bf16_t pu[4];
  auto prefetchA = [&](int np) {
    const size_t idx = idx0 + np;
    const int n = dir ? nch - 1 - np : np;
    const int tb = seqi * L + n * 64;
    pgl = GC[idx * 64 + 63];
    pge = GC[idx * 64 + w * 16 + fr];
    pgv = *(const float4*)(GC + idx * 64 + w * 16 + fq * 4);
    const bf16_t* qb = QKV + h * 128 + c4;
    pq0 = *(const uint4*)(qb + (size_t)(tb + (dir ? 63 - r5 : r5)) * 1536);
    pq1 = *(const uint4*)(qb + (size_t)(tb + (dir ? 31 - r5 : r5 + 32)) * 1536);
    const bf16_t* wb = WB + idx * 8192 + (size_t)r5 * 128 + c4;
    pw0 = *(const uint4*)(wb); pw1 = *(const uint4*)(wb + 32 * 128);
#pragma unroll
    for (int r = 0; r < 4; r++) pu[r] = UB[idx * 8192 + (w * 16 + fq * 4 + r) * 128 + (ecol0 & 127) + fr];
  };
  auto prefetchB = [&](int np) {
    const size_t idx = idx0 + np;
    const int n = dir ? nch - 1 - np : np;
    const int tb = seqi * L + n * 64;
    const bf16_t* kb = QKV + 512 + h * 128 + c4;
    pk0 = *(const uint4*)(kb + (size_t)(tb + (dir ? 63 - r5 : r5)) * 1536);
    pk1 = *(const uint4*)(kb + (size_t)(tb + (dir ? 31 - r5 : r5 + 32)) * 1536);
    pa0 = *(const uint4*)(AI + idx * 4096 + (size_t)r6 * 64 + c3);
  };
  prefetchA(0);
  prefetchB(0);
#pragma unroll 1
  for (int np = 0; np < nch; np++) {
    const int n = dir ? nch - 1 - np : np;
    const int tb = seqi * L + n * 64;
    const float gl = pgl;
    const bf16_t* Sc = St + (np & 1) * (16 * 136);
    bf16_t* Sn = St + ((np + 1) & 1) * (16 * 136);
    *(uint4*)(Ws + r5 * 136 + c4) = pw0;
    *(uint4*)(Ws + (r5 + 32) * 136 + c4) = pw1;
    *(uint4*)(Qs + r5 * 136 + c4) = pq0;
    *(uint4*)(Qs + (r5 + 32) * 136 + c4) = pq1;
    const float eg = __expf(pge);
    const float ek0 = __expf(gl - pgv.x), ek1 = __expf(gl - pgv.y), ek2 = __expf(gl - pgv.z), ek3 = __expf(gl - pgv.w);
    const float ur0 = bf2f(pu[0]), ur1 = bf2f(pu[1]), ur2 = bf2f(pu[2]), ur3 = bf2f(pu[3]);
    if (np + 1 < nch) prefetchA(np + 1);
    lds_barrier();
    f32x4 accV = f32x4{0, 0, 0, 0}, accQ = f32x4{0, 0, 0, 0};
#pragma unroll
    for (int ks = 0; ks < 4; ks++) {
      const bf16x8 aw = *(const bf16x8*)(Ws + (w * 16 + fr) * 136 + ks * 32 + fq * 8);
      const bf16x8 aq = *(const bf16x8*)(Qs + (w * 16 + fr) * 136 + ks * 32 + fq * 8);
      const bf16x8 bb = *(const bf16x8*)(Sc + fr * 136 + ks * 32 + fq * 8);
      accV = MFMA(aw, bb, accV);
      accQ = MFMA(bb, aq, accQ);
    }
    {
      f32x4 vn, vk;
      vn[0] = ur0 - accV[0]; vn[1] = ur1 - accV[1]; vn[2] = ur2 - accV[2]; vn[3] = ur3 - accV[3];
      vk[0] = vn[0] * ek0; vk[1] = vn[1] * ek1; vk[2] = vn[2] * ek2; vk[3] = vn[3] * ek3;
      *(uint2*)(Vnt + fr * 72 + w * 16 + fq * 4) = pack4(vn);
      *(uint2*)(Vnk + fr * 72 + w * 16 + fq * 4) = pack4(vk);
    }
    *(uint4*)(Ks + r5 * 144 + c4) = pk0;
    *(uint4*)(Ks + (r5 + 32) * 144 + c4) = pk1;
    *(uint4*)(As + r6 * 72 + c3) = pa0;
    if (np + 1 < nch) prefetchB(np + 1);
    lds_barrier();
    const float dS = __expf(gl);
#pragma unroll
    for (int r = 0; r < 4; r++) { accS[0][r] *= dS; accS[1][r] *= dS; }
    bf16x8 kfr[2][2];
    {
      const unsigned kb = (unsigned)(size_t)Ks + (unsigned)((fq * 8 + (fr >> 2)) * 288 + (2 * w) * 32 + (fr & 3) * 8);
      s16x4 t0, t1, t2, t3, t4, t5v, t6, t7;
      TR8(kb, 0, 1152, 32, 1184, 9216, 10368, 9248, 10400, t0, t1, t2, t3, t4, t5v, t6, t7);
      kfr[0][0] = cat8(t0, t1); kfr[0][1] = cat8(t2, t3); kfr[1][0] = cat8(t4, t5v); kfr[1][1] = cat8(t6, t7);
    }
    f32x4 accO = f32x4{0, 0, 0, 0};
#pragma unroll
    for (int ks = 0; ks < 2; ks++) {
      const bf16x8 aa = *(const bf16x8*)(As + (w * 16 + fr) * 72 + ks * 32 + fq * 8);
      const bf16x8 bn = *(const bf16x8*)(Vnt + fr * 72 + ks * 32 + fq * 8);
      const bf16x8 bk = *(const bf16x8*)(Vnk + fr * 72 + ks * 32 + fq * 8);
      accO = MFMA(bn, aa, accO);
      accS[0] = MFMA(kfr[ks][0], bk, accS[0]);
      accS[1] = MFMA(kfr[ks][1], bk, accS[1]);
    }
    {
      const int c = w * 16 + fr;
      const int tl = tb + (dir ? 63 - c : c);
      f32x4 o;
#pragma unroll
      for (int r = 0; r < 4; r++) o[r] = eg * accQ[r] + accO[r];
      *(uint2*)(OB + ((size_t)dir * TS + tl) * 512 + ecol0 + fq * 4) = pack4(o);
    }
    *(uint2*)(Sn + fr * 136 + (2 * w) * 16 + fq * 4) = pack4(accS[0]);
    *(uint2*)(Sn + fr * 136 + (2 * w + 1) * 16 + fq * 4) = pack4(accS[1]);
  }
  lds_barrier();
}

template <int NS>
DI void scan_item(const Params& p, int L, int nseq, int nch, int item, char* smem) {
  TILE_VARS
  char* const wsb = opaque_ptr(p.ws);
  bf16_t* St = (bf16_t*)smem;
  bf16_t* Vnt = (bf16_t*)(smem + 8704);
  bf16_t* Ws = (bf16_t*)(smem + 13312);
  bf16_t* Qgs = (bf16_t*)(smem + 30720);
  bf16_t* As = (bf16_t*)(smem + 48128);
  bf16_t* Kg = (bf16_t*)(smem + 57344);
  const bf16_t* QKV = (const bf16_t*)(wsb + O_QKV);
  const bf16_t* WB = (const bf16_t*)(wsb + O_WB);
  const bf16_t* UB = (const bf16_t*)(wsb + O_UB);
  const bf16_t* AI = (const bf16_t*)(wsb + O_AI);
  const float* GC = (const float*)(wsb + O_GC);
  bf16_t* OB = (bf16_t*)(wsb + O_OB);
  constexpr int NSL = 8 / NS;
  const int slice = item % NSL;
  int tmp = item / NSL;
  const int h = tmp & 3;
  tmp >>= 2;
  const int seqi = tmp % nseq, dir = tmp / nseq;
  const size_t idx0 = (size_t)((dir * nseq + seqi) * 4 + h) * nch;
  const int ecol0 = h * 128 + slice * NS * 16;

  for (int i = tid; i < 32 * 136 / 2; i += 256) ((unsigned*)St)[i] = 0u;
  f32x4 accS[2][NS];
#pragma unroll
  for (int a = 0; a < 2; a++)
#pragma unroll
    for (int b = 0; b < NS; b++) accS[a][b] = f32x4{0, 0, 0, 0};

  uint4 pw0, pw1, pw2, pw3, pq[4], pk[4], pa0, pa1;
  float pg[4], pgl;
  bf16_t pu[NS][4];
  auto prefetch = [&](int np) {
    const size_t idx = idx0 + np;
    const int n = dir ? nch - 1 - np : np;
    const int tb = seqi * L + n * 64;
    pgl = GC[idx * 64 + 63];
#pragma unroll
    for (int i = 0; i < 4; i++) {
      const int id = tid + i * 256, row = id >> 4, kc = id & 15;
      const int tl = tb + (dir ? 63 - row : row);
      const bf16_t* base = QKV + (size_t)tl * 1536 + h * 128 + kc * 8;
      pq[i] = *(const uint4*)(base);
      pk[i] = *(const uint4*)(base + 512);
      pg[i] = GC[idx * 64 + row];
    }
    pw0 = *(const uint4*)(WB + idx * 8192 + (size_t)(tid >> 4) * 128 + (tid & 15) * 8);
    pw1 = *(const uint4*)(WB + idx * 8192 + (size_t)((tid >> 4) + 16) * 128 + (tid & 15) * 8);
    pw2 = *(const uint4*)(WB + idx * 8192 + (size_t)((tid >> 4) + 32) * 128 + (tid & 15) * 8);
    pw3 = *(const uint4*)(WB + idx * 8192 + (size_t)((tid >> 4) + 48) * 128 + (tid & 15) * 8);
    pa0 = *(const uint4*)(AI + idx * 4096 + (size_t)(tid >> 3) * 64 + (tid & 7) * 8);
    pa1 = *(const uint4*)(AI + idx * 4096 + (size_t)((tid >> 3) + 32) * 64 + (tid & 7) * 8);
#pragma unroll
    for (int j = 0; j < NS; j++)
#pragma unroll
      for (int r = 0; r < 4; r++) pu[j][r] = UB[idx * 8192 + (w * 16 + fq * 4 + r) * 128 + (ecol0 & 127) + j * 16 + fr];
  };
  prefetch(0);
#pragma unroll 1
  for (int np = 0; np < nch; np++) {
    const int n = dir ? nch - 1 - np : np;
    const int tb = seqi * L + n * 64;
    const float gl = pgl;
#pragma unroll
    for (int i = 0; i < 4; i++) {
      const int id = tid + i * 256, row = id >> 4, kc = id & 15;
      const float eg = __expf(pg[i]), ek = __expf(gl - pg[i]);
      const uint4 q = pq[i], k = pk[i];
      uint4 qo;
      qo.x = pack2(lo2f(q.x) * eg, hi2f(q.x) * eg);
      qo.y = pack2(lo2f(q.y) * eg, hi2f(q.y) * eg);
      qo.z = pack2(lo2f(q.z) * eg, hi2f(q.z) * eg);
      qo.w = pack2(lo2f(q.w) * eg, hi2f(q.w) * eg);
      *(uint4*)(Qgs + row * 136 + kc * 8) = qo;
      uint4 ko;
      ko.x = pack2(lo2f(k.x) * ek, hi2f(k.x) * ek);
      ko.y = pack2(lo2f(k.y) * ek, hi2f(k.y) * ek);
      ko.z = pack2(lo2f(k.z) * ek, hi2f(k.z) * ek);
      ko.w = pack2(lo2f(k.w) * ek, hi2f(k.w) * ek);
      *(uint4*)(Kg + row * 144 + kc * 8) = ko;
    }
    *(uint4*)(Ws + (tid >> 4) * 136 + (tid & 15) * 8) = pw0;
    *(uint4*)(Ws + ((tid >> 4) + 16) * 136 + (tid & 15) * 8) = pw1;
    *(uint4*)(Ws + ((tid >> 4) + 32) * 136 + (tid & 15) * 8) = pw2;
    *(uint4*)(Ws + ((tid >> 4) + 48) * 136 + (tid & 15) * 8) = pw3;
    *(uint4*)(As + (tid >> 3) * 72 + (tid & 7) * 8) = pa0;
    *(uint4*)(As + ((tid >> 3) + 32) * 72 + (tid & 7) * 8) = pa1;
    float ureg[NS][4];
#pragma unroll
    for (int j = 0; j < NS; j++)
#pragma unroll
      for (int r = 0; r < 4; r++) ureg[j][r] = bf2f(pu[j][r]);
    if (np + 1 < nch) prefetch(np + 1);
    lds_barrier();
    f32x4 accV[NS], accO[NS];
#pragma unroll
    for (int j = 0; j < NS; j++) { accV[j] = f32x4{0, 0, 0, 0}; accO[j] = f32x4{0, 0, 0, 0}; }
#pragma unroll
    for (int ks = 0; ks < 4; ks++) {
      const bf16x8 aw = *(const bf16x8*)(Ws + (w * 16 + fr) * 136 + ks * 32 + fq * 8);
      const bf16x8 aq = *(const bf16x8*)(Qgs + (w * 16 + fr) * 136 + ks * 32 + fq * 8);
#pragma unroll
      for (int j = 0; j < NS; j++) {
        const bf16x8 b = *(const bf16x8*)(St + (j * 16 + fr) * 136 + ks * 32 + fq * 8);
        accV[j] = MFMA(aw, b, accV[j]);
        accO[j] = MFMA(b, aq, accO[j]);
      }
    }
#pragma unroll
    for (int j = 0; j < NS; j++) {
      f32x4 vn;
#pragma unroll
      for (int r = 0; r < 4; r++) vn[r] = ureg[j][r] - accV[j][r];
      *(uint2*)(Vnt + (j * 16 + fr) * 72 + w * 16 + fq * 4) = pack4(vn);
    }
    lds_barrier();
    const float dS = __expf(gl);
#pragma unroll
    for (int a = 0; a < 2; a++)
#pragma unroll
      for (int b = 0; b < NS; b++)
#pragma unroll
        for (int r = 0; r < 4; r++) accS[a][b][r] *= dS;
    bf16x8 kfr[2][2];
    {
      const unsigned kb = (unsigned)(size_t)Kg + (unsigned)((fq * 8 + (fr >> 2)) * 288 + (2 * w) * 32 + (fr & 3) * 8);
      s16x4 t0, t1, t2, t3, t4, t5, t6, t7;
      TR8(kb, 0, 1152, 32, 1184, 9216, 10368, 9248, 10400, t0, t1, t2, t3, t4, t5, t6, t7);
      kfr[0][0] = cat8(t0, t1); kfr[0][1] = cat8(t2, t3); kfr[1][0] = cat8(t4, t5); kfr[1][1] = cat8(t6, t7);
    }
#pragma unroll
    for (int ks = 0; ks < 2; ks++) {
      const bf16x8 aa = *(const bf16x8*)(As + (w * 16 + fr) * 72 + ks * 32 + fq * 8);
#pragma unroll
      for (int j = 0; j < NS; j++) {
        const bf16x8 b = *(const bf16x8*)(Vnt + (j * 16 + fr) * 72 + ks * 32 + fq * 8);
        accO[j] = MFMA(b, aa, accO[j]);
        accS[0][j] = MFMA(kfr[ks][0], b, accS[0][j]);
        accS[1][j] = MFMA(kfr[ks][1], b, accS[1][j]);
      }
    }
    {
      const int c = w * 16 + fr;
      const int tl = tb + (dir ? 63 - c : c);
#pragma unroll
      for (int j = 0; j < NS; j++)
        *(uint2*)(OB + ((size_t)dir * TS + tl) * 512 + ecol0 + j * 16 + fq * 4) = pack4(accO[j]);
    }
    lds_barrier();
#pragma unroll
    for (int mi = 0; mi < 2; mi++)
#pragma unroll
      for (int j = 0; j < NS; j++)
        *(uint2*)(St + (j * 16 + fr) * 136 + (2 * w + mi) * 16 + fq * 4) = pack4(accS[mi][j]);
  }
  lds_barrier();
}

using pg8::Unit;
#define EPI_FOR8                                    \
  _Pragma("unroll") for (int ai = 0; ai < 2; ++ai)  \
  _Pragma("unroll") for (int m = 0; m < 4; ++m)     \
  _Pragma("unroll") for (int bj = 0; bj < 2; ++bj)
#define EPI_COL8 (u.pn * 256 + bj * 128 + wc * 32 + fq * 8)
DI uint4 pack8(const f32x4& a, const f32x4& b) { return make_uint4(pack2(a[0], a[1]), pack2(a[2], a[3]), pack2(b[0], b[1]), pack2(b[2], b[3])); }
DI void unpack8(const uint4& g, float (&f)[8]) {
  f[0] = lo2f(g.x); f[1] = hi2f(g.x); f[2] = lo2f(g.y); f[3] = hi2f(g.y);
  f[4] = lo2f(g.z); f[5] = hi2f(g.z); f[6] = lo2f(g.w); f[7] = hi2f(g.w);
}
struct EpiKV {
  static constexpr bool PERM = true;
  bf16_t* KB; bf16_t* VT;
  DI void operator()(const Acc8& acc, const Unit& u, int wr, int wc, int fr, int fq) const {
    EPI_FOR8 {
      const int row = EPI_ROW, col = EPI_COL8;
      const int b = row >> 8, mm = row & 255;
      const f32x4 v0 = acc[ai][bj][m][0], v1 = acc[ai][bj][m][1];
      if (col < 1024) {
        const int hh = col >> 8, d = col & 255;
        *(uint4*)(KB + ((size_t)(b * 4 + hh) * 256 + mm) * 256 + d) = pack8(v0, v1);
      } else {
        const int c2 = col - 1024, hh = c2 >> 8, d = c2 & 255;
#pragma unroll
        for (int r = 0; r < 4; r++) {
          VT[((size_t)(b * 4 + hh) * 256 + d + r) * 256 + mm] = f2bf(v0[r]);
          VT[((size_t)(b * 4 + hh) * 256 + d + 4 + r) * 256 + mm] = f2bf(v1[r]);
        }
      }
    }
  }
};
struct EpiProj {
  static constexpr bool PERM = true;
  bf16_t* PROJ; float* AB;
  DI void operator()(const Acc8& acc, const Unit& u, int wr, int wc, int fr, int fq) const {
    if (u.pn == 20) {
      if (wc == 0 && fq < 2) {
#pragma unroll
        for (int ai = 0; ai < 2; ++ai)
#pragma unroll
          for (int m = 0; m < 4; ++m) {
            const int row = u.pm * 256 + ai * 128 + wr * 64 + m * 16 + fr;
            const f32x4 v0 = acc[ai][0][m][0], v1 = acc[ai][0][m][1];
            *(float4*)(AB + (size_t)row * 16 + fq * 8) = make_float4(v0[0], v0[1], v0[2], v0[3]);
            *(float4*)(AB + (size_t)row * 16 + fq * 8 + 4) = make_float4(v1[0], v1[1], v1[2], v1[3]);
          }
      }
      return;
    }
    const int mode = u.pn >= 12 ? 3 : 0;
    EPI_FOR8 {
      const int row = EPI_ROW, col = EPI_COL8;
      f32x4 v0 = acc[ai][bj][m][0], v1 = acc[ai][bj][m][1];
      if (mode == 3) {
#pragma unroll
        for (int r = 0; r < 4; r++) { v0[r] = sigmoidf_(v0[r]); v1[r] = sigmoidf_(v1[r]); }
      } else if (mode == 2) {
#pragma unroll
        for (int r = 0; r < 4; r++) { v0[r] = geluf_(v0[r]); v1[r] = geluf_(v1[r]); }
      } else if (mode == 1) {
#pragma unroll
        for (int r = 0; r < 4; r++) { v0[r] = siluf_(v0[r]); v1[r] = siluf_(v1[r]); }
      }
      *(uint4*)(PROJ + (size_t)row * 5120 + col) = pack8(v0, v1);
    }
  }
};
template <int PASS>
struct EpiMerge {
  static constexpr bool PERM = true;
  const bf16_t* PROJ; bf16_t* MERGED;
  DI void operator()(const Acc8& acc, const Unit& u, int wr, int wc, int fr, int fq) const {
#pragma unroll
    for (int ai = 0; ai < 2; ++ai) {
      uint4 gr[4][2], mr[4][2];
#pragma unroll
      for (int m = 0; m < 4; ++m)
#pragma unroll
        for (int bj = 0; bj < 2; ++bj) {
          gr[m][bj] = *(const uint4*)(PROJ + (size_t)EPI_ROW * 5120 + (PASS ? 4096 : 3072) + EPI_COL8);
          if (PASS) mr[m][bj] = *(const uint4*)(MERGED + (size_t)EPI_ROW * 1024 + EPI_COL8);
        }
      asm volatile("" ::: "memory");
#pragma unroll
      for (int m = 0; m < 4; ++m)
#pragma unroll
        for (int bj = 0; bj < 2; ++bj) {
          float g[8];
          unpack8(gr[m][bj], g);
          f32x4 v0 = acc[ai][bj][m][0], v1 = acc[ai][bj][m][1];
#pragma unroll
          for (int r = 0; r < 4; r++) { v0[r] *= g[r]; v1[r] *= g[4 + r]; }
          if (PASS) {
            float mo[8];
            unpack8(mr[m][bj], mo);
#pragma unroll
            for (int r = 0; r < 4; r++) { v0[r] += mo[r]; v1[r] += mo[4 + r]; }
          }
          *(uint4*)(MERGED + (size_t)EPI_ROW * 1024 + EPI_COL8) = pack8(v0, v1);
        }
    }
  }
};
struct EpiWout {
  static constexpr bool PERM = false;
  const float* xin; float* out;
  DI void operator()(const Acc8& acc, const Unit& u, int wr, int wc, int fr, int fq) const {
#pragma unroll
    for (int ai = 0; ai < 2; ++ai) {
      float4 xi[4][2][2];
#pragma unroll
      for (int m = 0; m < 4; ++m)
#pragma unroll
        for (int bj = 0; bj < 2; ++bj)
#pragma unroll
          for (int n = 0; n < 2; ++n) xi[m][bj][n] = *(const float4*)(xin + (size_t)EPI_ROW * 1024 + EPI_COL);
      asm volatile("" ::: "memory");
#pragma unroll
      for (int m = 0; m < 4; ++m)
#pragma unroll
        for (int bj = 0; bj < 2; ++bj)
#pragma unroll
          for (int n = 0; n < 2; ++n) {
            const f32x4 v = acc[ai][bj][m][n];
            const float4 x = xi[m][bj][n];
            *(float4*)(out + (size_t)EPI_ROW * 1024 + EPI_COL) = make_float4(x.x + v[0], x.y + v[1], x.z + v[2], x.w + v[3]);
          }
    }
  }
};
struct EpiQ {
  static constexpr bool PERM = true;
  bf16_t* QX;
  DI void operator()(const Acc8& acc, const Unit& u, int wr, int wc, int fr, int fq) const {
    EPI_FOR8 {
      f32x4 v0 = acc[ai][bj][m][0], v1 = acc[ai][bj][m][1];
#pragma unroll
      for (int r = 0; r < 4; r++) { v0[r] *= 0.0625f; v1[r] *= 0.0625f; }
      *(uint4*)(QX + (size_t)EPI_ROW * 1024 + EPI_COL8) = pack8(v0, v1);
    }
  }
};
struct EpiGateUp {
  static constexpr bool PERM = true;
  bf16_t* ACT;
  DI void operator()(const Acc8& acc, const Unit& u, int wr, int wc, int fr, int fq) const {
#pragma unroll
    for (int ai = 0; ai < 2; ++ai)
#pragma unroll
      for (int m = 0; m < 4; ++m) {
        const int row = u.pm * 256 + ai * 128 + wr * 64 + m * 16 + fr;
        const int col = u.pn * 128 + wc * 32 + fq * 8;
        f32x4 v0, v1;
#pragma unroll
        for (int r = 0; r < 4; r++) {
          v0[r] = siluf_(acc[ai][0][m][0][r]) * acc[ai][1][m][0][r];
          v1[r] = siluf_(acc[ai][0][m][1][r]) * acc[ai][1][m][1][r];
        }
        *(uint4*)(ACT + (size_t)row * 2816 + col) = pack8(v0, v1);
      }
  }
};

#define GW_VARS const int gw = VB() * 4 + w, nw = VGRID() * 4;

DI void phase_prologue(const Params& p, char* smem) {
  char* ws = opaque_ptr(p.ws);
  transpose_weight(p.w_in, 1024, 5136, (bf16_t*)(ws + O_WIN), 5376, 1, smem);
  transpose_weight(p.xa_w_kv, 1024, 2048, (bf16_t*)(ws + O_WKV), 2048, 0, smem);
  TILE_VARS
  GW_VARS
  bf16_t* SGW = (bf16_t*)(ws + O_SGW);
  for (int i = VB() * 256 + tid; i < 65536; i += VGRID() * 256) SGW[i] = f2bf(p.sg_w[i]);
  bf16_t* HB = (bf16_t*)(ws + O_HB);
  for (int t = gw * 4; t < TS; t += nw * 4)
    rownorm4_bf16([&](int tt) { return xrow(p, tt); }, t, p.norm_mix_w, HB + (size_t)t * 1024, lane);
  bf16_t* MEMN = (bf16_t*)(ws + O_MEMN);
  for (int t = gw * 4; t < 6144; t += nw * 4)
    rownorm4_bf16([&](int tt) { return tt < 2048 ? p.mem_prompt + (size_t)tt * 1024 : p.mem_sample + (size_t)(tt - 2048) * 1024; }, t,
                  p.norm_mem_w, MEMN + (size_t)t * 1024, lane);
}

DI void phase_conv(const Params& p, int L) {
  TILE_VARS
  GW_VARS
  char* ws = opaque_ptr(p.ws);
  const bf16_t* PROJ = (const bf16_t*)(ws + O_PROJ);
  bf16_t* QKV = (bf16_t*)(ws + O_QKV);
  float* LNST = (float*)(ws + O_LNST);
  const int nItems = 3 * (TS / 16);
  for (int item = gw; item < nItems; item += nw) {
    const int g = item % 3, run = item / 3;
    const int t0 = run * 16;
    const int seqb = (t0 / L) * L, l0 = t0 - seqb;
    const int ch = g * 512 + lane * 8;
    float cw[5][8];
#pragma unroll
    for (int j = 0; j < 5; j++) {
      const float4 a = *(const float4*)(p.conv_w + j * 1536 + ch);
      const float4 b = *(const float4*)(p.conv_w + j * 1536 + ch + 4);
      cw[j][0] = a.x; cw[j][1] = a.y; cw[j][2] = a.z; cw[j][3] = a.w;
      cw[j][4] = b.x; cw[j][5] = b.y; cw[j][6] = b.z; cw[j][7] = b.w;
    }
    uint4 raw[20];
#pragma unroll
    for (int j = 0; j < 20; j++) {
      const int l = l0 - 2 + j;
      raw[j] = (l >= 0 && l < L) ? *(const uint4*)(PROJ + (size_t)(seqb + l) * 5120 + ch) : make_uint4(0u, 0u, 0u, 0u);
    }
#pragma unroll
    for (int tt = 0; tt < 16; tt++) {
      float o[8];
#pragma unroll
      for (int e = 0; e < 8; e++) o[e] = 0.f;
#pragma unroll
      for (int j = 0; j < 5; j++) {
        const uint4 v = raw[tt + j];
        o[0] += cw[j][0] * lo2f(v.x); o[1] += cw[j][1] * hi2f(v.x); o[2] += cw[j][2] * lo2f(v.y); o[3] += cw[j][3] * hi2f(v.y);
        o[4] += cw[j][4] * lo2f(v.z); o[5] += cw[j][5] * hi2f(v.z); o[6] += cw[j][6] * lo2f(v.w); o[7] += cw[j][7] * hi2f(v.w);
      }
      float ss = 0.f;
#pragma unroll
      for (int e = 0; e < 8; e++) {
        o[e] = siluf_(o[e]);
        ss += o[e] * o[e];
      }
      if (g < 2) {
        ss = sum16(ss);
        const float sc = rsqrtf(ss + 1e-6f) * (g == 0 ? 0.08838834764831845f : 1.f);
#pragma unroll
        for (int e = 0; e < 8; e++) o[e] *= sc;
      }
      uint4 pk;
      pk.x = pack2(o[0], o[1]); pk.y = pack2(o[2], o[3]); pk.z = pack2(o[4], o[5]); pk.w = pack2(o[6], o[7]);
      *(uint4*)(QKV + (size_t)(t0 + tt) * 1536 + ch) = pk;
    }
  }
  for (int t = gw * 4; t < TS; t += nw * 4) {
    uint4 vv[4];
#pragma unroll
    for (int r = 0; r < 4; r++) vv[r] = *(const uint4*)(PROJ + (size_t)(t + r) * 5120 + 2560 + lane * 8);
#pragma unroll
    for (int r = 0; r < 4; r++) {
      const uint4 v = vv[r];
      float f[8] = {geluf_(lo2f(v.x)), geluf_(hi2f(v.x)), geluf_(lo2f(v.y)), geluf_(hi2f(v.y)),
                    geluf_(lo2f(v.z)), geluf_(hi2f(v.z)), geluf_(lo2f(v.w)), geluf_(hi2f(v.w))};
      float sm = 0.f;
#pragma unroll
      for (int e = 0; e < 8; e++) sm += f[e];
      const float mu = wave_sum(sm) * (1.f / 512.f);
      float q = 0.f;
#pragma unroll
      for (int e = 0; e < 8; e++) q += (f[e] - mu) * (f[e] - mu);
      const float var = wave_sum(q) * (1.f / 512.f);
      if (lane == 0) {
        LNST[(size_t)(t + r) * 2] = mu;
        LNST[(size_t)(t + r) * 2 + 1] = rsqrtf(var + 1e-6f);
      }
    }
  }
}

DI void phase_dnout(const Params& p) {
  TILE_VARS
  GW_VARS
  char* ws = opaque_ptr(p.ws);
  const bf16_t* PROJ = (const bf16_t*)(ws + O_PROJ);
  const bf16_t* OB = (const bf16_t*)(ws + O_OB);
  bf16_t* DNO = (bf16_t*)(ws + O_DNO);
  const float4 nw0 = *(const float4*)(p.dn_norm_w + (lane & 15) * 8);
  const float4 nw1 = *(const float4*)(p.dn_norm_w + (lane & 15) * 8 + 4);
  const float nwv[8] = {nw0.x, nw0.y, nw0.z, nw0.w, nw1.x, nw1.y, nw1.z, nw1.w};
  for (int t4 = gw * 4; t4 < TS; t4 += nw * 4) {
    uint4 av[4], bv[4], gv[4];
#pragma unroll
    for (int r = 0; r < 4; r++) {
      av[r] = *(const uint4*)(OB + (size_t)(t4 + r) * 512 + lane * 8);
      bv[r] = *(const uint4*)(OB + ((size_t)TS + t4 + r) * 512 + lane * 8);
      gv[r] = *(const uint4*)(PROJ + (size_t)(t4 + r) * 5120 + 1536 + lane * 8);
    }
#pragma unroll
    for (int r = 0; r < 4; r++) {
      const uint4 a = av[r], b = bv[r], gt = gv[r];
      float o[8] = {lo2f(a.x) + lo2f(b.x), hi2f(a.x) + hi2f(b.x), lo2f(a.y) + lo2f(b.y), hi2f(a.y) + hi2f(b.y),
                    lo2f(a.z) + lo2f(b.z), hi2f(a.z) + hi2f(b.z), lo2f(a.w) + lo2f(b.w), hi2f(a.w) + hi2f(b.w)};
      const float gg[8] = {siluf_(lo2f(gt.x)), siluf_(hi2f(gt.x)), siluf_(lo2f(gt.y)), siluf_(hi2f(gt.y)),
                           siluf_(lo2f(gt.z)), siluf_(hi2f(gt.z)), siluf_(lo2f(gt.w)), siluf_(hi2f(gt.w))};
      float ss = 0.f;
#pragma unroll
      for (int e = 0; e < 8; e++) ss += o[e] * o[e];
      ss = sum16(ss);
      const float rs = rsqrtf(ss * (1.f / 128.f) + 1e-6f);
#pragma unroll
      for (int e = 0; e < 8; e++) o[e] = o[e] * rs * nwv[e] * gg[e];
      uint4 pk;
      pk.x = pack2(o[0], o[1]); pk.y = pack2(o[2], o[3]); pk.z = pack2(o[4], o[5]); pk.w = pack2(o[6], o[7]);
      *(uint4*)(DNO + (size_t)(t4 + r) * 512 + lane * 8) = pk;
    }
  }
}

DI void phase_norm_out(const Params& p, const float* wgt) {
  TILE_VARS
  GW_VARS
  bf16_t* HB = (bf16_t*)(opaque_ptr(p.ws) + O_HB);
  const float* outp = p.out;
  for (int t = gw * 4; t < NTOK; t += nw * 4)
    rownorm4_bf16([&](int tt) { return outp + (size_t)tt * 1024; }, t, wgt, HB + (size_t)t * 1024, lane);
}

DI void phase_final(const Params& p) {
  TILE_VARS
  GW_VARS
  float4 ww[4];
#pragma unroll
  for (int i = 0; i < 4; i++) ww[i] = ((const float4*)p.final_norm_w)[lane + i * 64];
  for (int t = gw * 4; t < NTOK; t += nw * 4) {
    float* rowp = p.out + (size_t)t * 1024;
    float4 v[4][4];
#pragma unroll
    for (int r = 0; r < 4; r++)
#pragma unroll
      for (int i = 0; i < 4; i++) v[r][i] = ld_stream(rowp + r * 1024 + (lane + i * 64) * 4);
#pragma unroll
    for (int r = 0; r < 4; r++) {
      float ss = 0.f;
#pragma unroll
      for (int i = 0; i < 4; i++) ss += v[r][i].x * v[r][i].x + v[r][i].y * v[r][i].y + v[r][i].z * v[r][i].z + v[r][i].w * v[r][i].w;
      ss = wave_sum(ss);
      const float rs = rsqrtf(ss * (1.f / 1024.f) + 1e-6f);
#pragma unroll
      for (int i = 0; i < 4; i++)
        ((float4*)(rowp + r * 1024))[lane + i * 64] =
            make_float4(v[r][i].x * rs * ww[i].x, v[r][i].y * rs * ww[i].y, v[r][i].z * rs * ww[i].z, v[r][i].w * rs * ww[i].w);
    }
  }
}

__global__ void __launch_bounds__(512, 2) fwd_megakernel(Params p) {
  extern __shared__ __attribute__((aligned(16))) char dyn_smem[];
  cg::grid_group grid = cg::this_grid();
  LAS unsigned char* glds = (LAS unsigned char*)dyn_smem;
  char* smem = dyn_smem + __builtin_amdgcn_readfirstlane(threadIdx.x >> 8) * HALF_LDS;
  char* ws = opaque_ptr(p.ws);
  const bf16_t* HB = (const bf16_t*)(ws + O_HB);
  volatile LAS unsigned* xst = (volatile LAS unsigned*)(glds + LDS_BYTES);
  if (threadIdx.x == 0) { xst[0] = 0u; xst[1] = 0u; }
  __syncthreads();
  const XcdBarrier xb = xcd_barrier_post((unsigned*)(ws + O_BAR), xst);

  phase_prologue(p, smem);
  grid.sync();
#pragma unroll 1
  for (int slab = 0; slab < 3; slab++) {
    const int tok0 = slab * TS;
    const int L = slab < 2 ? 8192 : 2048;
    const int nseq = slab < 2 ? 4 : 16;
    const int nch = L / 64;
    {
      EpiProj E{(bf16_t*)(ws + O_PROJ), (float*)(ws + O_AB)};
      pg8::gemm_phase(glds, pg8::Gemm{HB + (size_t)tok0 * 1024, (const bf16_t*)(ws + O_WIN), TS, 5376, 1024, 1024, 1024}, E);
    }
    xcd_barrier(xb);
    phase_conv(p, L);
    xcd_barrier(xb);
    {
      const int nPrep = 2 * nseq * 4 * nch;
#pragma unroll 1
      for (int item = VB(); item < nPrep; item += VGRID()) prep_item(p, L, nseq, nch, item, smem);
      if (slab == 2) {
#pragma unroll 1
        for (int item = VB(); item < 1024; item += VGRID()) sgmix_item(p, item, smem);
      }
    }
    xcd_barrier(xb);
    if (slab < 2) {
      const int nScan = 2 * nseq * 4 * 8;
      if (VB() < nScan) {
        const int bx = blockIdx.x, xcd = bx & 7, j = bx >> 3;
        const int chain = (j >> 2) * 8 + xcd;
        scan_pair16(p, L, nseq, nch, chain, j & 3, dyn_smem);
      } else {
#pragma unroll 1
        for (int item = VB() - nScan; item < 1024; item += VGRID() - nScan) sgmix_item(p, item, smem);
        {
          const int vb_ = VB() - nScan, vg_ = VGRID() - nScan;
          const int tid_ = opaque_tid() & 255, lane_ = tid_ & 63, w_ = tid_ >> 6;
          const int gw_ = vb_ * 4 + w_, nw_ = vg_ * 4;
          bf16_t* HBw = (bf16_t*)(ws + O_HB);
          if (slab == 0) {
            transpose_weight(p.w_up_a, 512, 1024, (bf16_t*)(ws + O_WUPA), 1024, 0, smem, vb_, vg_);
            transpose_weight(p.w_up_b, 512, 1024, (bf16_t*)(ws + O_WUPB), 1024, 0, smem, vb_, vg_);
            transpose_weight(p.w_out, 1024, 1024, (bf16_t*)(ws + O_WOUT), 1024, 0, smem, vb_, vg_);
            const int nIdle = (int)gridDim.x - nScan / 2;
            EpiKV E{(bf16_t*)(ws + O_KB), (bf16_t*)(ws + O_VT)};
            pg8::gemm_phase(glds, pg8::Gemm{(const bf16_t*)(ws + O_MEMN), (const bf16_t*)(ws + O_WKV), 6144, 2048, 1024, 1024, 1024}, E, nIdle,
                            (int)blockIdx.x - nScan / 2);
            for (int t = TS + gw_ * 4; t < 2 * TS; t += nw_ * 4)
              rownorm4_bf16([&](int tt) { return xrow(p, tt); }, t, p.norm_mix_w, HBw + (size_t)t * 1024, lane_);
          } else {
            transpose_weight(p.xa_w_q, 1024, 1024, (bf16_t*)(ws + O_WQ), 1024, 0, smem, vb_, vg_);
            transpose_weight(p.xa_w_o, 1024, 1024, (bf16_t*)(ws + O_WO), 1024, 0, smem, vb_, vg_);
            transpose_weight(p.ffn_w_gu, 1024, 5632, (bf16_t*)(ws + O_WGU), 5632, 2, smem, vb_, vg_);
            transpose_weight(p.ffn_w_down, 2816, 1024, (bf16_t*)(ws + O_WDN), 1024, 0, smem, vb_, vg_);
            for (int t = 2 * TS + gw_ * 4; t < NTOK; t += nw_ * 4)
              rownorm4_bf16([&](int tt) { return xrow(p, tt); }, t, p.norm_mix_w, HBw + (size_t)t * 1024, lane_);
          }
        }
      }
    } else {
      const int bx = blockIdx.x, xcd = bx & 7, j = bx >> 3;
      const int chain = (j >> 1) * 8 + xcd, slice = 2 * (j & 1) + __builtin_amdgcn_readfirstlane(threadIdx.x >> 8);
      scan_item<2>(p, L, nseq, nch, chain * 4 + slice, smem);
    }
    xcd_barrier(xb);
    phase_dnout(p);
    xcd_barrier(xb);
    {
      EpiMerge<0> E0{(const bf16_t*)(ws + O_PROJ), (bf16_t*)(ws + O_MERGED)};
      pg8::gemm_phase(glds, pg8::Gemm{(const bf16_t*)(ws + O_DNO), (const bf16_t*)(ws + O_WUPA), TS, 1024, 512, 512, 512}, E0);
      EpiMerge<1> E1{(const bf16_t*)(ws + O_PROJ), (bf16_t*)(ws + O_MERGED)};
      pg8::gemm_phase(glds, pg8::Gemm{(const bf16_t*)(ws + O_PROJ) + 2048, (const bf16_t*)(ws + O_WUPB), TS, 1024, 512, 5120, 512}, E1);
    }
    xcd_barrier(xb);
    {
      EpiWout E{slab < 2 ? p.x_prompt + (size_t)tok0 * 1024 : p.x_sample, p.out + (size_t)tok0 * 1024};
      pg8::gemm_phase(glds, pg8::Gemm{(const bf16_t*)(ws + O_MERGED), (const bf16_t*)(ws + O_WOUT), TS, 1024, 1024, 1024, 1024}, E);
    }
    xcd_barrier(xb);
  }

  phase_norm_out(p, p.norm_xa_w);
  xcd_barrier(xb);
  {
    EpiQ E{(bf16_t*)(ws + O_QX)};
    pg8::gemm_phase(glds, pg8::Gemm{HB, (const bf16_t*)(ws + O_WQ), NTOK, 1024, 1024, 1024, 1024}, E);
  }
  xcd_barrier(xb);
#pragma unroll 1
  for (int item = VB(); item < (NTOK / 64) * 4; item += VGRID()) attn_item(p, item, smem);
  xcd_barrier(xb);
  {
    EpiWout E{p.out, p.out};
    pg8::gemm_phase(glds, pg8::Gemm{(const bf16_t*)(ws + O_ATT), (const bf16_t*)(ws + O_WO), NTOK, 1024, 1024, 1024, 1024}, E);
  }
  xcd_barrier(xb);
  phase_norm_out(p, p.norm_ffn_w);
  xcd_barrier(xb);
  {
    EpiGateUp E{(bf16_t*)(ws + O_ACT)};
    pg8::gemm_phase(glds, pg8::Gemm{HB, (const bf16_t*)(ws + O_WGU), NTOK, 5632, 1024, 1024, 1024}, E);
  }
  xcd_barrier(xb);
  {
    EpiWout E{p.out, p.out};
    pg8::gemm_phase(glds, pg8::Gemm{(const bf16_t*)(ws + O_ACT), (const bf16_t*)(ws + O_WDN), NTOK, 1024, 2816, 2816, 2816}, E);
  }
  xcd_barrier(xb);
  phase_final(p);
}

extern "C" void kernel_launch(void* const* d_in, const int* in_sizes, int n_in, void* d_out, int out_size, void* d_ws,
                              size_t ws_size, hipStream_t stream) {
  static int grid_blocks = 0;
  if (!grid_blocks) {
    (void)hipFuncSetAttribute((const void*)fwd_megakernel, hipFuncAttributeMaxDynamicSharedMemorySize, LDS_BYTES + 16);
    int per_cu = 0;
    (void)hipOccupancyMaxActiveBlocksPerMultiprocessor(&per_cu, fwd_megakernel, 512, LDS_BYTES + 16);
    grid_blocks = 256;
    if (per_cu < 1) fprintf(stderr, "occupancy query returned %d\n", per_cu);
  }
  Params p{};
  const float** pp = (const float**)&p;
  for (int i = 0; i < 26; i++) pp[i] = (const float*)d_in[i];
  p.out = (float*)d_out;
  p.ws = (char*)d_ws;
  void* args[] = {&p};
  (void)hipMemsetAsync(d_ws, 0, XCD_BAR_WORDS * 4, stream);
  hipError_t e = hipLaunchCooperativeKernel((void*)fwd_megakernel, dim3(grid_blocks), dim3(512), args, LDS_BYTES + 16, stream);
  if (e != hipSuccess) fprintf(stderr, "cooperative launch failed: %s (grid %d)\n", hipGetErrorString(e), grid_blocks);
}
```

```cpp
#include <hip/hip_runtime.h>
#include <hip/hip_cooperative_groups.h>
#include <cstdio>
namespace cg = cooperative_groups;

typedef unsigned short bf16_t;
typedef __attribute__((ext_vector_type(8))) short bf16x8;
typedef __attribute__((ext_vector_type(4))) float f32x4;
#define DI __device__ __forceinline__
#define MFMA(a, b, c) __builtin_amdgcn_mfma_f32_16x16x32_bf16((a), (b), (c), 0, 0, 0)

constexpr int NTOK = 98304, NPT = 65536, TS = 32768;
constexpr int HALF_LDS = 76032;
constexpr int LDS_BYTES = 2 * HALF_LDS;

constexpr size_t O_BAR = 0;
constexpr size_t O_WIN = 16384;
constexpr size_t O_WUPA = O_WIN + 5376ull * 1024 * 2;
constexpr size_t O_WUPB = O_WUPA + 1024ull * 512 * 2;
constexpr size_t O_WOUT = O_WUPB + 1024ull * 512 * 2;
constexpr size_t O_WQ = O_WOUT + 1024ull * 1024 * 2;
constexpr size_t O_WKV = O_WQ + 1024ull * 1024 * 2;
constexpr size_t O_WO = O_WKV + 2048ull * 1024 * 2;
constexpr size_t O_WGU = O_WO + 1024ull * 1024 * 2;
constexpr size_t O_WDN = O_WGU + 5632ull * 1024 * 2;
constexpr size_t O_SGW = O_WDN + 1024ull * 2816 * 2;
constexpr size_t O_MEMN = O_SGW + 4ull * 128 * 128 * 2;
constexpr size_t O_KB = O_MEMN + 6144ull * 1024 * 2;
constexpr size_t O_VT = O_KB + 6144ull * 1024 * 2;
constexpr size_t O_HB = O_VT + 6144ull * 1024 * 2;
constexpr size_t O_S = O_HB + 98304ull * 1024 * 2;
constexpr size_t O_PROJ = O_S;
constexpr size_t O_AB = O_PROJ + 32768ull * 5120 * 2;
constexpr size_t O_QKV = O_AB + 32768ull * 16 * 4;
constexpr size_t O_LNST = O_QKV + 32768ull * 1536 * 2;
constexpr size_t O_WB = O_LNST + 32768ull * 2 * 4;
constexpr size_t O_UB = O_WB + 2ull * 32768 * 512 * 2;
constexpr size_t O_AI = O_UB + 2ull * 32768 * 512 * 2;
constexpr size_t O_GC = O_AI + 2ull * 32768 * 4 * 64 * 2;
constexpr size_t O_OB = O_GC + 2ull * 32768 * 4 * 4;
constexpr size_t O_MERGED = O_QKV;
constexpr size_t O_DNO = O_AI;
constexpr size_t O_QX = O_S;
constexpr size_t O_ATT = O_S + 98304ull * 1024 * 2;
constexpr size_t O_ACT = O_S;

struct Params {
  const float *x_prompt, *x_sample, *mem_prompt, *mem_sample, *norm_mix_w, *w_in, *conv_w, *a_log, *dt_bias,
      *dn_norm_w, *w_up_a, *sg_ln_w, *sg_ln_b, *sg_w, *sg_b, *w_up_b, *w_out, *norm_xa_w, *norm_mem_w, *xa_w_q,
      *xa_w_kv, *xa_w_o, *norm_ffn_w, *ffn_w_gu, *ffn_w_down, *final_norm_w;
  float* out;
  char* ws;
};

typedef __bf16 hbf16x2 __attribute__((ext_vector_type(2)));
typedef float hf32x2 __attribute__((ext_vector_type(2)));
DI unsigned pack2(float a, float b) { const hf32x2 v = {a, b}; const hbf16x2 h = __builtin_convertvector(v, hbf16x2); return __builtin_bit_cast(unsigned, h); }
DI bf16_t f2bf(float x) { return (bf16_t)(pack2(x, x) & 0xffffu); }
DI float bf2f(bf16_t h) { return __uint_as_float(((unsigned)h) << 16); }
DI float lo2f(unsigned u) { return __uint_as_float(u << 16); }
DI float hi2f(unsigned u) { return __uint_as_float(u & 0xffff0000u); }
DI uint2 pack4(f32x4 v) { return make_uint2(pack2(v[0], v[1]), pack2(v[2], v[3])); }
DI float sigmoidf_(float x) { return __builtin_amdgcn_rcpf(1.f + __expf(-x)); }
DI float siluf_(float x) { return x * sigmoidf_(x); }
DI float geluf_(float x) { float z = 0.7978845608f * (x + 0.044715f * x * x * x); return x * sigmoidf_(2.f * z); }
template <int CTRL> DI float dpp_rot(float v) {
  return __builtin_bit_cast(float, __builtin_amdgcn_mov_dpp(__builtin_bit_cast(int, v), CTRL, 0xF, 0xF, true));
}
DI float sum16(float v) {
  v += dpp_rot<0x128>(v);
  v += dpp_rot<0x124>(v);
  v += dpp_rot<0x122>(v);
  v += dpp_rot<0x121>(v);
  return v;
}
DI float max16(float v) {
  v = fmaxf(v, dpp_rot<0x128>(v));
  v = fmaxf(v, dpp_rot<0x124>(v));
  v = fmaxf(v, dpp_rot<0x122>(v));
  v = fmaxf(v, dpp_rot<0x121>(v));
  return v;
}
DI float wave_sum(float v) {
  v = sum16(v);
  v += __shfl_xor(v, 16);
  v += __shfl_xor(v, 32);
  return v;
}
typedef __attribute__((ext_vector_type(4))) float f32x4_ld;
DI float4 ld_stream(const float* p) { const f32x4_ld t = __builtin_nontemporal_load((const f32x4_ld*)p); return make_float4(t[0], t[1], t[2], t[3]); }
typedef __attribute__((ext_vector_type(4))) unsigned u32x4_ld;
DI uint4 ld_stream16(const void* p) { const u32x4_ld t = __builtin_nontemporal_load((const u32x4_ld*)p); return make_uint4(t[0], t[1], t[2], t[3]); }
DI const float* xrow(const Params& p, int t) {
  return t < NPT ? p.x_prompt + (size_t)t * 1024 : p.x_sample + (size_t)(t - NPT) * 1024;
}


DI int VB() { return blockIdx.x * 2 + __builtin_amdgcn_readfirstlane(threadIdx.x >> 8); }
DI int VGRID() { return gridDim.x * 2; }
DI int opaque_tid() { int t = threadIdx.x; asm volatile("" : "+v"(t)); return t; }
DI void lds_barrier() { asm volatile("s_waitcnt lgkmcnt(0)" ::: "memory"); __builtin_amdgcn_s_barrier(); asm volatile("" ::: "memory"); }
typedef __attribute__((address_space(1))) char gchar_t;
DI char* opaque_ptr(char* q) { gchar_t* g = (gchar_t*)q; asm volatile("" : "+s"(g)); return (char*)g; }
DI void zero_acc(f32x4 (&acc)[4][4]) {
#pragma unroll
  for (int i = 0; i < 4; i++)
#pragma unroll
    for (int j = 0; j < 4; j++) acc[i][j] = f32x4{0.f, 0.f, 0.f, 0.f};
}

#define LAS __attribute__((address_space(3)))
namespace pg8 {
constexpr int BM = 256, BK = 64, HALF = 128, HTB = HALF * BK * 2, NXCD = 8, WGM = 8;
DI int lds_byte(int r, int c) { const int st = (r >> 4) * 2 + (c >> 5), rr = r & 15, cc = c & 31, ob = rr * 64 + cc * 2; return st * 1024 + (ob ^ (((ob >> 9) & 1) << 5)); }
DI int perm32(int rho) { const int n = rho >> 4, i = rho & 15; return 8 * (i >> 2) + 4 * n + (i & 3); }
DI void stage_rc(int b, int& R, int& C) { const int st = b / 1024, sb = b % 1024, swz = sb ^ (((sb >> 9) & 1) << 5); R = (st >> 1) * 16 + swz / 64; C = (st & 1) * 32 + (swz % 64) / 2; }
struct Unit { int pm, pn; };
struct Gemm { const bf16_t* A; const bf16_t* Bt; int M, N, K, lda, ldb; };
struct StaticOrder {
  int nM, nN, nwg, G, c;
  DI void init(int M, int N, int G_, int c_) { nM = M / BM; nN = N / BM; nwg = nM * nN; G = G_; c = c_; }
  DI bool next(int i, Unit& u) const {
    const long L = (long)i * G + c; if (L >= nwg) return false;
    int wgid = (int)L; { const int q = nwg / NXCD, r = nwg % NXCD, xcd = wgid % NXCD, off = wgid / NXCD; wgid = (xcd < r ? xcd * (q + 1) : r * (q + 1) + (xcd - r) * q) + off; }
    const int nig = WGM * nN, gid = wgid / nig, fm = gid * WGM, gsz = (nM - fm) < WGM ? (nM - fm) : WGM;
    u.pm = fm + ((wgid % nig) % gsz); u.pn = (wgid % nig) / gsz; return true;
  }
};
template <class Epi>
DI void gemm_phase(LAS unsigned char* lds, const Gemm g, const Epi& E, int G_ = -1, int c_ = 0) {
  const int tid = opaque_tid(), wid = __builtin_amdgcn_readfirstlane(tid >> 6), lane = tid & 63, wr = wid >> 2, wc = wid & 3, fr = lane & 15, fq = lane >> 4;
  const int K = g.K, nt = K / BK;
  StaticOrder S; if (G_ > 0) S.init(g.M, g.N, G_, c_); else S.init(g.M, g.N, (int)gridDim.x, (int)blockIdx.x);
  unsigned voffA[2], voffB[2];
#pragma unroll
  for (int i = 0; i < 2; ++i) { int R, C; stage_rc(tid * 16 + i * 8192, R, C);
    const int Rb = Epi::PERM ? ((R & ~31) + perm32(R & 31)) : R;
    voffA[i] = (unsigned)(R * g.lda + C) * 2u; voffB[i] = (unsigned)(Rb * g.ldb + C) * 2u; }
  const size_t kstep = (size_t)(BK * 2);
  const size_t hstepA = (size_t)HALF * g.lda * 2, hstepB = (size_t)HALF * g.ldb * 2;
  const size_t tstepA = 2 * hstepA, tstepB = 2 * hstepB;
  const unsigned ldsw = (unsigned)wid * 1024u;
  const int aoff = lds_byte(wr * 64 + fr, fq * 8), boff = lds_byte(wc * 32 + fr, fq * 8);
#define PG8_SA(b, h) (((b) * 2 + (h)) * HTB)
#define PG8_SB(b, h) ((4 + (b) * 2 + (h)) * HTB)
#define PG8_STAGE(bufoff, gbase, voff) do { _Pragma("unroll") for (int _i = 0; _i < 2; ++_i) \
    __builtin_amdgcn_global_load_lds((const unsigned*)((const char*)(gbase) + (voff)[_i]), (LAS unsigned*)(lds + (bufoff) + ldsw + _i * 8192), 16, 0, 0); } while (0)
#define PG8_LDA(dst, b, h) do { _Pragma("unroll") for (int m = 0; m < 4; ++m) _Pragma("unroll") for (int k = 0; k < 2; ++k) dst[m][k] = *(const LAS bf16x8*)(lds + PG8_SA(b, h) + aoff + m * 2048 + k * 1024); } while (0)
#define PG8_LDB(dst, b, h) do { _Pragma("unroll") for (int n = 0; n < 2; ++n) _Pragma("unroll") for (int k = 0; k < 2; ++k) dst[n][k] = *(const LAS bf16x8*)(lds + PG8_SB(b, h) + boff + n * 2048 + k * 1024); } while (0)
#define PG8_MMA(ai, bj, At, Bt) do { __builtin_amdgcn_s_setprio(1); _Pragma("unroll") for (int m = 0; m < 4; ++m) _Pragma("unroll") for (int n = 0; n < 2; ++n) _Pragma("unroll") for (int k = 0; k < 2; ++k) \
    acc[ai][bj][m][n] = __builtin_amdgcn_mfma_f32_16x16x32_bf16(Bt[n][k], At[m][k], acc[ai][bj][m][n], 0, 0, 0); __builtin_amdgcn_s_setprio(0); } while (0)
#define PG8_WAIT_V(n) asm volatile("s_waitcnt vmcnt(" #n ")" ::: "memory")
#define PG8_WAIT_L(n) asm volatile("s_waitcnt lgkmcnt(" #n ")" ::: "memory")
#define PG8_BAR __builtin_amdgcn_s_barrier()
#define PG8_SCHED __builtin_amdgcn_sched_barrier(0)
  Unit cur, nxt; int ui = 0;
  if (!S.next(0, cur)) return;
  f32x4 acc[2][2][4][2];
#pragma unroll
  for (int a = 0; a < 2; ++a)
#pragma unroll
    for (int b = 0; b < 2; ++b)
#pragma unroll
      for (int m = 0; m < 4; ++m)
#pragma unroll
        for (int n = 0; n < 2; ++n) acc[a][b][m][n] = (f32x4){0.f, 0.f, 0.f, 0.f};
  bf16x8 At[4][2], B0[2][2], B1[2][2];
  const char* cA = (const char*)g.A + (size_t)cur.pm * tstepA; const char* cB = (const char*)g.Bt + (size_t)cur.pn * tstepB;
  PG8_STAGE(PG8_SB(0, 0), cB, voffB); PG8_STAGE(PG8_SA(0, 0), cA, voffA); PG8_STAGE(PG8_SB(0, 1), cB + hstepB, voffB); PG8_STAGE(PG8_SA(0, 1), cA + hstepA, voffA);
  if (wr == 1) PG8_BAR;
  PG8_WAIT_V(4); PG8_BAR;
  PG8_STAGE(PG8_SB(1, 0), cB + kstep, voffB); PG8_STAGE(PG8_SA(1, 0), cA + kstep, voffA); PG8_STAGE(PG8_SB(1, 1), cB + hstepB + kstep, voffB);
  PG8_WAIT_V(6); PG8_BAR;
  for (;;) {
    const bool has_next = S.next(ui + 1, nxt);
    const char* nA = has_next ? (const char*)g.A + (size_t)nxt.pm * tstepA : cA; const char* nB = has_next ? (const char*)g.Bt + (size_t)nxt.pn * tstepB : cB;
    for (int t = 0; t < nt; t += 2) {
      const bool last = (t == nt - 2);
      const char* a1 = cA + (size_t)(t + 1) * kstep;
      const char* a2 = last ? nA : cA + (size_t)(t + 2) * kstep; const char* b2 = last ? nB : cB + (size_t)(t + 2) * kstep;
      const char* a3 = a2 + kstep; const char* b3 = b2 + kstep;
      PG8_LDB(B0, 0, 0); PG8_SCHED; PG8_LDA(At, 0, 0); PG8_STAGE(PG8_SA(1, 1), a1 + hstepA, voffA);
      PG8_WAIT_L(8); PG8_BAR; PG8_WAIT_L(0); PG8_MMA(0, 0, At, B0); PG8_BAR; PG8_SCHED;
      PG8_LDB(B1, 0, 1); PG8_STAGE(PG8_SB(0, 0), b2, voffB);
      PG8_BAR; PG8_WAIT_L(0); PG8_MMA(0, 1, At, B1); PG8_BAR;
      PG8_LDA(At, 0, 1); PG8_STAGE(PG8_SA(0, 0), a2, voffA);
      PG8_BAR; PG8_WAIT_L(0); PG8_MMA(1, 0, At, B0); PG8_BAR; PG8_SCHED;
      PG8_STAGE(PG8_SB(0, 1), b2 + hstepB, voffB);
      PG8_WAIT_V(6); PG8_BAR; PG8_MMA(1, 1, At, B1); PG8_BAR;
      PG8_LDB(B0, 1, 0); PG8_SCHED; PG8_LDA(At, 1, 0); PG8_STAGE(PG8_SA(0, 1), a2 + hstepA, voffA);
      PG8_WAIT_L(8); PG8_BAR; PG8_WAIT_L(0); PG8_MMA(0, 0, At, B0); PG8_BAR; PG8_SCHED;
      PG8_LDB(B1, 1, 1); PG8_STAGE(PG8_SB(1, 0), b3, voffB);
      PG8_BAR; PG8_WAIT_L(0); PG8_MMA(0, 1, At, B1); PG8_BAR;
      PG8_LDA(At, 1, 1); PG8_STAGE(PG8_SA(1, 0), a3, voffA);
      PG8_BAR; PG8_WAIT_L(0); PG8_MMA(1, 0, At, B0); PG8_BAR; PG8_SCHED;
      PG8_STAGE(PG8_SB(1, 1), b3 + hstepB, voffB);
      PG8_WAIT_V(6); PG8_BAR; PG8_MMA(1, 1, At, B1); PG8_BAR;
    }
    E(acc, cur, wr, wc, fr, fq);
    if (!has_next) break;
#pragma unroll
    for (int a = 0; a < 2; ++a)
#pragma unroll
      for (int b = 0; b < 2; ++b)
#pragma unroll
        for (int m = 0; m < 4; ++m)
#pragma unroll
          for (int n = 0; n < 2; ++n) acc[a][b][m][n] = (f32x4){0.f, 0.f, 0.f, 0.f};
    cur = nxt; cA = nA; cB = nB; ++ui;
  }
  PG8_WAIT_V(0);
  if (wr == 0) PG8_BAR;
  PG8_BAR;
#undef PG8_SA
#undef PG8_SB
#undef PG8_STAGE
#undef PG8_LDA
#undef PG8_LDB
#undef PG8_MMA
#undef PG8_WAIT_V
#undef PG8_WAIT_L
#undef PG8_BAR
#undef PG8_SCHED
}
}

#define XB_TMO      128
#define XB_XCNT(j)  (256  + 64 * (j))
#define XB_XSUB(j)  (1280 + 64 * (j))
#define XB_XGEN(j)  (2304 + 64 * (j))
#define XB_TOP      3328
#define XB_TOPGEN   3392
#define XCD_BAR_WORDS 3456
#define XB_SPIN_CAP (1u << 18)
DI unsigned xb_ld(unsigned* p) { return __hip_atomic_load(p, __ATOMIC_RELAXED, __HIP_MEMORY_SCOPE_AGENT); }
DI unsigned xb_add(unsigned* p, unsigned v) { return __hip_atomic_fetch_add(p, v, __ATOMIC_RELAXED, __HIP_MEMORY_SCOPE_AGENT); }
DI unsigned xb_xcc_id() { return (unsigned)__builtin_amdgcn_s_getreg((3 << 11) | 20) & 0xFu; }
#define XB_SPIN(cond, bar) do { unsigned _sp = 0; while (cond) { __builtin_amdgcn_s_sleep(1); \
    if ((++_sp & 255u) == 0u) { if (xb_ld(&(bar)[XB_TMO])) break; if (_sp > XB_SPIN_CAP) { atomicAdd(&(bar)[XB_TMO], 1u); break; } } } } while (0)
struct XcdBarrier { unsigned* bar; unsigned x; volatile LAS unsigned* st; };
DI XcdBarrier xcd_barrier_post(unsigned* bar, volatile LAS unsigned* st) {
  XcdBarrier b; b.bar = bar; b.x = xb_xcc_id(); b.st = st;
  if (threadIdx.x == 0) (void)xb_add(&bar[XB_XCNT(b.x)], 1u);
  return b;
}
DI void xcd_barrier_complete(unsigned* bar, unsigned x, unsigned& nloc, unsigned& nx) {
  const unsigned G = gridDim.x * gridDim.y * gridDim.z;
  unsigned sum, cnt, mine, sp = 0u;
  for (;;) {
    sum = 0u; cnt = 0u; mine = 0u;
#pragma unroll
    for (unsigned j = 0; j < 16; ++j) { const unsigned c = xb_ld(&bar[XB_XCNT(j)]); sum += c; cnt += (c > 0u) ? 1u : 0u; mine = (j == x) ? c : mine; }
    if (sum == G) break;
    __builtin_amdgcn_s_sleep(1);
    if ((++sp & 255u) == 0u) { if (xb_ld(&bar[XB_TMO])) break; if (sp > XB_SPIN_CAP) { atomicAdd(&bar[XB_TMO], 1u); break; } }
  }
  nloc = mine > 0u ? mine : 1u; nx = cnt > 0u ? cnt : 1u;
}
DI void xcd_barrier(const XcdBarrier& b) {
  asm volatile("s_waitcnt vmcnt(0)" ::: "memory");
  __syncthreads();
  if (threadIdx.x == 0) {
    unsigned* bar = b.bar;
    __builtin_amdgcn_s_waitcnt(0);
    unsigned nloc = b.st[0], nx = b.st[1];
    if (nloc == 0u) { xcd_barrier_complete(bar, b.x, nloc, nx); b.st[0] = nloc; b.st[1] = nx; }
    const unsigned old = xb_add(&bar[XB_XSUB(b.x)], 1u);
    const unsigned gen = old / nloc;
    if (old + 1u == (gen + 1u) * nloc) {
      __builtin_amdgcn_fence(__ATOMIC_RELEASE, "agent");
      asm volatile("s_waitcnt vmcnt(0)" ::: "memory");
      const unsigned og = xb_add(&bar[XB_TOP], 1u);
      const unsigned tg = og / nx;
      if (og + 1u == (tg + 1u) * nx) xb_add(&bar[XB_TOPGEN], 1u);
      else XB_SPIN(xb_ld(&bar[XB_TOPGEN]) == tg, bar);
      __builtin_amdgcn_fence(__ATOMIC_ACQUIRE, "agent");
      xb_add(&bar[XB_XGEN(b.x)], 1u);
      asm volatile("s_waitcnt vmcnt(0)" ::: "memory");
    } else {
      XB_SPIN(xb_ld(&bar[XB_XGEN(b.x)]) == gen, bar);
      __builtin_amdgcn_fence(__ATOMIC_ACQUIRE, "agent");
      asm volatile("s_waitcnt vmcnt(0)" ::: "memory");
    }
  }
  __syncthreads();
}

typedef __attribute__((ext_vector_type(4))) short s16x4;
#define TR8(base, o0, o1, o2, o3, o4, o5, o6, o7, r0, r1, r2, r3, r4, r5, r6, r7)                                    \
  asm volatile("ds_read_b64_tr_b16 %0, %8 offset:%9\n\tds_read_b64_tr_b16 %1, %8 offset:%10\n\t"                      \
               "ds_read_b64_tr_b16 %2, %8 offset:%11\n\tds_read_b64_tr_b16 %3, %8 offset:%12\n\t"                     \
               "ds_read_b64_tr_b16 %4, %8 offset:%13\n\tds_read_b64_tr_b16 %5, %8 offset:%14\n\t"                     \
               "ds_read_b64_tr_b16 %6, %8 offset:%15\n\tds_read_b64_tr_b16 %7, %8 offset:%16\n\ts_waitcnt lgkmcnt(0)" \
               : "=&v"(r0), "=&v"(r1), "=&v"(r2), "=&v"(r3), "=&v"(r4), "=&v"(r5), "=&v"(r6), "=&v"(r7)               \
               : "v"(base), "n"(o0), "n"(o1), "n"(o2), "n"(o3), "n"(o4), "n"(o5), "n"(o6), "n"(o7)                    \
               : "memory")
DI bf16x8 cat8(s16x4 lo, s16x4 hi) { return __builtin_shufflevector(lo, hi, 0, 1, 2, 3, 4, 5, 6, 7); }

typedef f32x4 Acc8[2][2][4][2];
#define EPI_FOR                                   \
  _Pragma("unroll") for (int ai = 0; ai < 2; ++ai) \
  _Pragma("unroll") for (int m = 0; m < 4; ++m)    \
  _Pragma("unroll") for (int bj = 0; bj < 2; ++bj) \
  _Pragma("unroll") for (int n = 0; n < 2; ++n)
#define EPI_ROW (u.pm * 256 + ai * 128 + wr * 64 + m * 16 + fr)
#define EPI_COL (u.pn * 256 + bj * 128 + wc * 32 + n * 16 + fq * 4)

#define TILE_VARS                                                                                      \
  const int tid = opaque_tid() & 255, lane = tid & 63, w = tid >> 6, wr = w >> 1, wc = w & 1, fr = lane & 15, \
            fq = lane >> 4;                                                                            \
  (void)tid; (void)lane; (void)w; (void)wr; (void)wc; (void)fr; (void)fq;

DI int map_col(int mode, int n) {
  if (mode == 0) return n;
  if (mode == 1) {
    if (n < 1536) return n;
    if (n < 5120) return n + 16;
    if (n < 5136) return 1536 + (n - 5120);
    return -1;
  }
  int q = n >> 8, s = n & 255;
  return s < 128 ? q * 128 + s : 2816 + q * 128 + (s - 128);
}
DI void transpose_weight(const float* __restrict__ src, int K, int Nsrc, bf16_t* __restrict__ dst, int Ndst, int mode,
                         char* smem, int vb = -1, int vgrid = 0) {
  if (vb < 0) { vb = VB(); vgrid = VGRID(); }
  float* tile = (float*)smem;
  const int tid = opaque_tid() & 255;
  const int nkt = K >> 6, nnt = Ndst >> 6, ntile = nkt * nnt;
  for (int t = vb; t < ntile; t += vgrid) {
    const int kt = t / nnt, nt = t % nnt;
    {
      const int nn = tid & 63, kk0 = tid >> 6;
      const int sc = map_col(mode, nt * 64 + nn);
#pragma unroll
      for (int i = 0; i < 16; i++) {
        const int kk = kk0 + i * 4;
        tile[kk * 65 + nn] = sc >= 0 ? src[(size_t)(kt * 64 + kk) * Nsrc + sc] : 0.f;
      }
    }
    __syncthreads();
    {
      const int kk = (tid & 31) * 2, nn0 = tid >> 5;
#pragma unroll
      for (int i = 0; i < 8; i++) {
        const int nn = nn0 + i * 8;
        *(unsigned*)(dst + (size_t)(nt * 64 + nn) * K + kt * 64 + kk) = pack2(tile[kk * 65 + nn], tile[(kk + 1) * 65 + nn]);
      }
    }
    __syncthreads();
  }
}

template <class SrcFn>
DI void rownorm4_bf16(SrcFn srcfn, int t0, const float* __restrict__ wgt, bf16_t* __restrict__ dst0, int lane) {
  float4 v[4][4];
#pragma unroll
  for (int r = 0; r < 4; r++) {
    const float* src = srcfn(t0 + r);
#pragma unroll
    for (int i = 0; i < 4; i++) v[r][i] = ld_stream(src + (lane + i * 64) * 4);
  }
  float4 ww[4];
#pragma unroll
  for (int i = 0; i < 4; i++) ww[i] = ((const float4*)wgt)[lane + i * 64];
#pragma unroll
  for (int r = 0; r < 4; r++) {
    float ss = 0.f;
#pragma unroll
    for (int i = 0; i < 4; i++) ss += v[r][i].x * v[r][i].x + v[r][i].y * v[r][i].y + v[r][i].z * v[r][i].z + v[r][i].w * v[r][i].w;
    ss = wave_sum(ss);
    const float rs = rsqrtf(ss * (1.f / 1024.f) + 1e-6f);
#pragma unroll
    for (int i = 0; i < 4; i++)
      ((uint2*)(dst0 + (size_t)r * 1024))[lane + i * 64] =
          make_uint2(pack2(v[r][i].x * rs * ww[i].x, v[r][i].y * rs * ww[i].y), pack2(v[r][i].z * rs * ww[i].z, v[r][i].w * rs * ww[i].w));
  }
}

DI void prep_item(const Params& p, int L, int nseq, int nch, int item, char* smem) {
  TILE_VARS
  char* const wsb = opaque_ptr(p.ws);
  bf16_t* Ks = (bf16_t*)smem;
  bf16_t* Qs = (bf16_t*)(smem + 17408);
  bf16_t* Vs = (bf16_t*)(smem + 34816);
  bf16_t* K2 = (bf16_t*)(smem + 53248);
  float* sGc = (float*)(smem + 71680);
  float* sBeta = sGc + 64;
  float* Ls = (float*)Qs;
  bf16_t* Ts = Ks;
  const bf16_t* QKV = (const bf16_t*)(wsb + O_QKV);
  const float* AB = (const float*)(wsb + O_AB);
  bf16_t* WB = (bf16_t*)(wsb + O_WB);
  bf16_t* UB = (bf16_t*)(wsb + O_UB);
  bf16_t* AI = (bf16_t*)(wsb + O_AI);
  float* GC = (float*)(wsb + O_GC);

  const int np = item % nch;
  int tmp = item / nch;
  const int h = tmp & 3;
  tmp >>= 2;
  const int seqi = tmp % nseq, dir = tmp / nseq;
  const int n = dir ? nch - 1 - np : np;
  const int tb = seqi * L + n * 64;

  uint4 kq0, kq1, kq2, kq3, kk[4], kv[4];
  {
    const int r4 = tid >> 4, kc = tid & 15;
    const bf16_t* base = QKV + h * 128 + kc * 8;
    const size_t o0 = (size_t)(tb + (dir ? 63 - r4 : r4)) * 1536, o1 = (size_t)(tb + (dir ? 47 - r4 : r4 + 16)) * 1536;
    const size_t o2 = (size_t)(tb + (dir ? 31 - r4 : r4 + 32)) * 1536, o3 = (size_t)(tb + (dir ? 15 - r4 : r4 + 48)) * 1536;
    kq0 = *(const uint4*)(base + o0); kq1 = *(const uint4*)(base + o1); kq2 = *(const uint4*)(base + o2); kq3 = *(const uint4*)(base + o3);
    kk[0] = *(const uint4*)(base + o0 + 512); kk[1] = *(const uint4*)(base + o1 + 512);
    kk[2] = *(const uint4*)(base + o2 + 512); kk[3] = *(const uint4*)(base + o3 + 512);
    kv[0] = *(const uint4*)(base + o0 + 1024); kv[1] = *(const uint4*)(base + o1 + 1024);
    kv[2] = *(const uint4*)(base + o2 + 1024); kv[3] = *(const uint4*)(base + o3 + 1024);
  }
  if (w == 0) {
    const int tl = tb + (dir ? 63 - lane : lane);
    const float* ab = AB + (size_t)tl * 16;
    const float bet = sigmoidf_(ab[dir * 4 + h]);
    const float xx = ab[8 + dir * 4 + h] + p.dt_bias[dir * 4 + h];
    const float ex = __expf(xx);
    const float sp = xx > 20.f ? xx : (ex < 0.03125f ? ex * (1.f - ex * (0.5f - ex * (0.33333334f - 0.25f * ex))) : __logf(1.f + ex));
    float gv = -__expf(p.a_log[dir * 4 + h]) * sp;
#pragma unroll
    for (int o = 1; o < 64; o <<= 1) {
      const float t = __shfl_up(gv, o);
      if (lane >= o) gv += t;
    }
    sGc[lane] = gv;
    sBeta[lane] = bet;
    GC[(size_t)item * 64 + lane] = gv;
  }
  {
    const int r4 = tid >> 4, kc = tid & 15;
    *(uint4*)(Qs + r4 * 136 + kc * 8) = kq0;
    *(uint4*)(Qs + (r4 + 16) * 136 + kc * 8) = kq1;
    *(uint4*)(Qs + (r4 + 32) * 136 + kc * 8) = kq2;
    *(uint4*)(Qs + (r4 + 48) * 136 + kc * 8) = kq3;
#pragma unroll
    for (int i = 0; i < 4; i++) *(uint4*)(Ks + (r4 + 16 * i) * 136 + kc * 8) = make_uint4(kk[i].x, kk[i].y, kk[i].z, kk[i].w);
  }
  lds_barrier();
#pragma unroll
  for (int i = 0; i < 4; i++) {
    const int id = tid + i * 256, s = id >> 4, kc = id & 15;
    const float b = sBeta[s];
    const float sk = b * __expf(sGc[s]);
    uint4 vo, ko;
    vo.x = pack2(lo2f(kv[i].x) * b, hi2f(kv[i].x) * b); vo.y = pack2(lo2f(kv[i].y) * b, hi2f(kv[i].y) * b);
    vo.z = pack2(lo2f(kv[i].z) * b, hi2f(kv[i].z) * b); vo.w = pack2(lo2f(kv[i].w) * b, hi2f(kv[i].w) * b);
    ko.x = pack2(lo2f(kk[i].x) * sk, hi2f(kk[i].x) * sk); ko.y = pack2(lo2f(kk[i].y) * sk, hi2f(kk[i].y) * sk);
    ko.z = pack2(lo2f(kk[i].z) * sk, hi2f(kk[i].z) * sk); ko.w = pack2(lo2f(kk[i].w) * sk, hi2f(kk[i].w) * sk);
    *(uint4*)(Vs + s * 144 + kc * 8) = vo;
    *(uint4*)(K2 + s * 144 + kc * 8) = ko;
  }
  f32x4 accG[4], accA[4];
#pragma unroll
  for (int j = 0; j < 4; j++) { accG[j] = f32x4{0, 0, 0, 0}; accA[j] = f32x4{0, 0, 0, 0}; }
#pragma unroll
  for (int ks = 0; ks < 4; ks++) {
    const bf16x8 ak = *(const bf16x8*)(Ks + (w * 16 + fr) * 136 + ks * 32 + fq * 8);
    const bf16x8 aq = *(const bf16x8*)(Qs + (w * 16 + fr) * 136 + ks * 32 + fq * 8);
#pragma unroll
    for (int j = 0; j < 4; j++) {
      const bf16x8 b = *(const bf16x8*)(Ks + (j * 16 + fr) * 136 + ks * 32 + fq * 8);
      accG[j] = MFMA(ak, b, accG[j]);
      accA[j] = MFMA(aq, b, accA[j]);
    }
  }
  lds_barrier();
#pragma unroll
  for (int j = 0; j < 4; j++) {
    const int s = j * 16 + fr;
    const float gs = sGc[s];
#pragma unroll
    for (int r = 0; r < 4; r++) {
      const int c = w * 16 + fq * 4 + r;
      const float dec = __expf(fminf(sGc[c] - gs, 0.f));
      Ls[c * 68 + s] = (s < c) ? sBeta[c] * accG[j][r] * dec : 0.f;
      AI[(size_t)item * 4096 + c * 64 + s] = f2bf((s <= c) ? accA[j][r] * dec : 0.f);
    }
  }
  lds_barrier();
  if (w == 0) {
    typedef float f32x2_t __attribute__((ext_vector_type(2)));
    f32x2_t tp[32];
#pragma unroll
    for (int i = 0; i < 64; i++) {
      f32x2_t a0 = {(i == lane) ? 1.f : 0.f, 0.f}, a1 = {0.f, 0.f};
#pragma unroll
      for (int jp = 0; jp < i / 2; jp++) {
        const f32x2_t lv = *(const f32x2_t*)(Ls + i * 68 + 2 * jp);
        if (jp & 1) a1 -= lv * tp[jp]; else a0 -= lv * tp[jp];
      }
      float ti = (a0[0] + a0[1]) + (a1[0] + a1[1]);
      if (i & 1) ti -= Ls[i * 68 + i - 1] * tp[(i - 1) >> 1][0];
      if (i & 1) tp[i >> 1][1] = ti; else tp[i >> 1][0] = ti;
      Ts[i * 72 + lane] = f2bf(ti);
    }
  }
  lds_barrier();
  f32x4 accU[8], accW[8];
#pragma unroll
  for (int j = 0; j < 8; j++) { accU[j] = f32x4{0, 0, 0, 0}; accW[j] = f32x4{0, 0, 0, 0}; }
  {
    const unsigned off = (unsigned)((fq * 8 + (fr >> 2)) * 288 + (fr & 3) * 8);
    const unsigned vb0 = (unsigned)(size_t)Vs + off, kb0 = (unsigned)(size_t)K2 + off;
#pragma unroll
    for (int ks = 0; ks < 2; ks++) {
      const bf16x8 a = *(const bf16x8*)(Ts + (w * 16 + fr) * 72 + ks * 32 + fq * 8);
      s16x4 l0, l1, l2, l3, l4, l5, l6, l7, h0, h1, h2, h3, h4, h5, h6, h7;
      if (ks == 0) {
        TR8(vb0, 0, 32, 64, 96, 128, 160, 192, 224, l0, l1, l2, l3, l4, l5, l6, l7);
        TR8(vb0, 1152, 1184, 1216, 1248, 1280, 1312, 1344, 1376, h0, h1, h2, h3, h4, h5, h6, h7);
      } else {
        TR8(vb0, 9216, 9248, 9280, 9312, 9344, 9376, 9408, 9440, l0, l1, l2, l3, l4, l5, l6, l7);
        TR8(vb0, 10368, 10400, 10432, 10464, 10496, 10528, 10560, 10592, h0, h1, h2, h3, h4, h5, h6, h7);
      }
      accU[0] = MFMA(cat8(l0, h0), a, accU[0]); accU[1] = MFMA(cat8(l1, h1), a, accU[1]);
      accU[2] = MFMA(cat8(l2, h2), a, accU[2]); accU[3] = MFMA(cat8(l3, h3), a, accU[3]);
      accU[4] = MFMA(cat8(l4, h4), a, accU[4]); accU[5] = MFMA(cat8(l5, h5), a, accU[5]);
      accU[6] = MFMA(cat8(l6, h6), a, accU[6]); accU[7] = MFMA(cat8(l7, h7), a, accU[7]);
      if (ks == 0) {
        TR8(kb0, 0, 32, 64, 96, 128, 160, 192, 224, l0, l1, l2, l3, l4, l5, l6, l7);
        TR8(kb0, 1152, 1184, 1216, 1248, 1280, 1312, 1344, 1376, h0, h1, h2, h3, h4, h5, h6, h7);
      } else {
        TR8(kb0, 9216, 9248, 9280, 9312, 9344, 9376, 9408, 9440, l0, l1, l2, l3, l4, l5, l6, l7);
        TR8(kb0, 10368, 10400, 10432, 10464, 10496, 10528, 10560, 10592, h0, h1, h2, h3, h4, h5, h6, h7);
      }
      accW[0] = MFMA(cat8(l0, h0), a, accW[0]); accW[1] = MFMA(cat8(l1, h1), a, accW[1]);
      accW[2] = MFMA(cat8(l2, h2), a, accW[2]); accW[3] = MFMA(cat8(l3, h3), a, accW[3]);
      accW[4] = MFMA(cat8(l4, h4), a, accW[4]); accW[5] = MFMA(cat8(l5, h5), a, accW[5]);
      accW[6] = MFMA(cat8(l6, h6), a, accW[6]); accW[7] = MFMA(cat8(l7, h7), a, accW[7]);
    }
  }
  {
    bf16_t* up = UB + (size_t)item * 8192 + (w * 16 + fr) * 128 + fq * 4;
    bf16_t* wp = WB + (size_t)item * 8192 + (w * 16 + fr) * 128 + fq * 4;
#pragma unroll
    for (int j = 0; j < 8; j++) {
      *(uint2*)(up + j * 16) = pack4(accU[j]);
      *(uint2*)(wp + j * 16) = pack4(accW[j]);
    }
  }
  lds_barrier();
}

DI void sgmix_item(const Params& p, int item, char* smem) {
  TILE_VARS
  char* const wsb = opaque_ptr(p.ws);
  bf16_t* As = (bf16_t*)smem;
  bf16_t* Bs = (bf16_t*)(smem + 34816);
  bf16_t* PROJ = (bf16_t*)(wsb + O_PROJ);
  const float* LNST = (const float*)(wsb + O_LNST);
  const bf16_t* SGW = (const bf16_t*)(wsb + O_SGW);
  const int g = item & 3, cb = item >> 2;
  const int t0 = cb * 128;
#pragma unroll
  for (int i = 0; i < 8; i++) {
    const int id = tid + i * 256, row = id >> 4, cc = id & 15;
    *(uint4*)(As + row * 136 + cc * 8) = *(const uint4*)(SGW + (size_t)g * 16384 + row * 128 + cc * 8);
    const uint4 v = *(const uint4*)(PROJ + (size_t)(t0 + row) * 5120 + 2560 + g * 128 + cc * 8);
    const float mu = LNST[(size_t)(t0 + row) * 2], rstd = LNST[(size_t)(t0 + row) * 2 + 1];
    const unsigned vv[4] = {v.x, v.y, v.z, v.w};
#pragma unroll
    for (int e = 0; e < 4; e++) {
      const int c0 = cc * 8 + 2 * e;
      const float w0 = p.sg_ln_w[g * 128 + c0], w1 = p.sg_ln_w[g * 128 + c0 + 1];
      const float b0 = p.sg_ln_b[g * 128 + c0], b1 = p.sg_ln_b[g * 128 + c0 + 1];
      Bs[c0 * 136 + row] = f2bf((geluf_(lo2f(vv[e])) - mu) * rstd * w0 + b0);
      Bs[(c0 + 1) * 136 + row] = f2bf((geluf_(hi2f(vv[e])) - mu) * rstd * w1 + b1);
    }
  }
  lds_barrier();
  f32x4 acc[4][4];
  zero_acc(acc);
#pragma unroll
  for (int ks = 0; ks < 4; ks++) {
    bf16x8 af[4], bfr[4];
#pragma unroll
    for (int i = 0; i < 4; i++) af[i] = *(const bf16x8*)(As + (wr * 64 + i * 16 + fr) * 136 + ks * 32 + fq * 8);
#pragma unroll
    for (int j = 0; j < 4; j++) bfr[j] = *(const bf16x8*)(Bs + (wc * 64 + j * 16 + fr) * 136 + ks * 32 + fq * 8);
#pragma unroll
    for (int i = 0; i < 4; i++)
#pragma unroll
      for (int j = 0; j < 4; j++) acc[i][j] = MFMA(bfr[j], af[i], acc[i][j]);
  }
  {
    uint2 ur[4][4];
#pragma unroll
    for (int i = 0; i < 4; i++)
#pragma unroll
      for (int j = 0; j < 4; j++)
        ur[i][j] = *(const uint2*)(PROJ + (size_t)(t0 + wr * 64 + i * 16 + fr) * 5120 + 2048 + g * 128 + wc * 64 + j * 16 + fq * 4);
    asm volatile("" ::: "memory");
#pragma unroll
    for (int i = 0; i < 4; i++) {
      const int t = wr * 64 + i * 16 + fr;
      const float bias = p.sg_b[g * 128 + t];
#pragma unroll
      for (int j = 0; j < 4; j++) {
        const int c = wc * 64 + j * 16 + fq * 4;
        const uint2 u = ur[i][j];
        f32x4 o;
        o[0] = geluf_(lo2f(u.x)) * (acc[i][j][0] + bias);
        o[1] = geluf_(hi2f(u.x)) * (acc[i][j][1] + bias);
        o[2] = geluf_(lo2f(u.y)) * (acc[i][j][2] + bias);
        o[3] = geluf_(hi2f(u.y)) * (acc[i][j][3] + bias);
        *(uint2*)(PROJ + (size_t)(t0 + t) * 5120 + 2048 + g * 128 + c) = pack4(o);
      }
    }
  }
  lds_barrier();
}

#define KV_LOAD(SRC)                                                                           \
  kr0 = *(const uint4*)((SRC) + (size_t)(tid >> 5) * 256 + (tid & 31) * 8);                    \
  kr1 = *(const uint4*)((SRC) + (size_t)((tid >> 5) + 8) * 256 + (tid & 31) * 8);              \
  kr2 = *(const uint4*)((SRC) + (size_t)((tid >> 5) + 16) * 256 + (tid & 31) * 8);             \
  kr3 = *(const uint4*)((SRC) + (size_t)((tid >> 5) + 24) * 256 + (tid & 31) * 8);             \
  kr4 = *(const uint4*)((SRC) + (size_t)((tid >> 5) + 32) * 256 + (tid & 31) * 8);             \
  kr5 = *(const uint4*)((SRC) + (size_t)((tid >> 5) + 40) * 256 + (tid & 31) * 8);             \
  kr6 = *(const uint4*)((SRC) + (size_t)((tid >> 5) + 48) * 256 + (tid & 31) * 8);             \
  kr7 = *(const uint4*)((SRC) + (size_t)((tid >> 5) + 56) * 256 + (tid & 31) * 8);
#define KV_STORE()                                                                             \
  *(uint4*)(KVs + ((tid >> 5)) * 264 + (tid & 31) * 8) = kr0;                                  \
  *(uint4*)(KVs + ((tid >> 5) + 8) * 264 + (tid & 31) * 8) = kr1;                              \
  *(uint4*)(KVs + ((tid >> 5) + 16) * 264 + (tid & 31) * 8) = kr2;                             \
  *(uint4*)(KVs + ((tid >> 5) + 24) * 264 + (tid & 31) * 8) = kr3;                             \
  *(uint4*)(KVs + ((tid >> 5) + 32) * 264 + (tid & 31) * 8) = kr4;                             \
  *(uint4*)(KVs + ((tid >> 5) + 40) * 264 + (tid & 31) * 8) = kr5;                             \
  *(uint4*)(KVs + ((tid >> 5) + 48) * 264 + (tid & 31) * 8) = kr6;                             \
  *(uint4*)(KVs + ((tid >> 5) + 56) * 264 + (tid & 31) * 8) = kr7;
DI void attn_item(const Params& p, int item, char* smem) {
  TILE_VARS
  char* const wsb = opaque_ptr(p.ws);
  bf16_t* Qs = (bf16_t*)smem;
  bf16_t* KVs = (bf16_t*)(smem + 33792);
  float* sL = (float*)(smem + 67584);
  bf16_t* Ps = Qs;
  const bf16_t* QX = (const bf16_t*)(wsb + O_QX);
  const bf16_t* KB = (const bf16_t*)(wsb + O_KB);
  const bf16_t* VT = (const bf16_t*)(wsb + O_VT);
  bf16_t* ATT = (bf16_t*)(wsb + O_ATT);
  const int head = item & 3, qt = item >> 2;
  const int t0 = qt * 64;
  const int b = t0 < NPT ? t0 / 8192 : 8 + (t0 - NPT) / 2048;
  const bf16_t* Kp = KB + ((size_t)(b * 4 + head)) * 65536;
  const bf16_t* Vp = VT + ((size_t)(b * 4 + head)) * 65536;
  uint4 kr0, kr1, kr2, kr3, kr4, kr5, kr6, kr7;
  KV_LOAD(Kp)
#pragma unroll
  for (int i = 0; i < 8; i++) {
    const int id = tid + i * 256, row = id >> 5, cc = id & 31;
    *(uint4*)(Qs + row * 264 + cc * 8) = *(const uint4*)(QX + (size_t)(t0 + row) * 1024 + head * 256 + cc * 8);
  }
  f32x4 sc[16];
#pragma unroll
  for (int t = 0; t < 16; t++) sc[t] = f32x4{0, 0, 0, 0};
#pragma unroll
  for (int kc = 0; kc < 4; kc++) {
    lds_barrier();
    KV_STORE()
    if (kc < 3) { KV_LOAD(Kp + (size_t)(kc + 1) * 64 * 256) } else { KV_LOAD(Vp) }
    lds_barrier();
#pragma unroll
    for (int ks = 0; ks < 8; ks++) {
      const bf16x8 a = *(const bf16x8*)(Qs + (w * 16 + fr) * 264 + ks * 32 + fq * 8);
#pragma unroll
      for (int j = 0; j < 4; j++) {
        const bf16x8 bb = *(const bf16x8*)(KVs + (j * 16 + fr) * 264 + ks * 32 + fq * 8);
        sc[kc * 4 + j] = MFMA(a, bb, sc[kc * 4 + j]);
      }
    }
  }
  float lsum[4];
#pragma unroll
  for (int r = 0; r < 4; r++) {
    float m = sc[0][r];
#pragma unroll
    for (int t = 1; t < 16; t++) m = fmaxf(m, sc[t][r]);
    m = max16(m);
    float sm = 0.f;
#pragma unroll
    for (int t = 0; t < 16; t++) {
      const float e = __expf(sc[t][r] - m);
      sc[t][r] = e;
      sm += e;
    }
    lsum[r] = sum16(sm);
  }
  lds_barrier();
  if (fr == 0) {
#pragma unroll
    for (int r = 0; r < 4; r++) sL[w * 16 + fq * 4 + r] = lsum[r];
  }
#pragma unroll
  for (int t = 0; t < 16; t++)
#pragma unroll
    for (int r = 0; r < 4; r++) Ps[(w * 16 + fq * 4 + r) * 264 + t * 16 + fr] = f2bf(sc[t][r]);
#pragma unroll
  for (int dc = 0; dc < 4; dc++) {
    if (dc > 0) lds_barrier();
    KV_STORE()
    if (dc < 3) { KV_LOAD(Vp + (size_t)(dc + 1) * 64 * 256) }
    lds_barrier();
    f32x4 o[4];
#pragma unroll
    for (int j = 0; j < 4; j++) o[j] = f32x4{0, 0, 0, 0};
#pragma unroll
    for (int ks = 0; ks < 8; ks++) {
      const bf16x8 pa = *(const bf16x8*)(Ps + (w * 16 + fr) * 264 + ks * 32 + fq * 8);
#pragma unroll
      for (int j = 0; j < 4; j++) {
        const bf16x8 bb = *(const bf16x8*)(KVs + (j * 16 + fr) * 264 + ks * 32 + fq * 8);
        o[j] = MFMA(bb, pa, o[j]);
      }
    }
    const float linv = 1.f / sL[w * 16 + fr];
#pragma unroll
    for (int j = 0; j < 4; j++) {
      f32x4 v = o[j];
#pragma unroll
      for (int r = 0; r < 4; r++) v[r] *= linv;
      *(uint2*)(ATT + (size_t)(t0 + w * 16 + fr) * 1024 + head * 256 + dc * 64 + j * 16 + fq * 4) = pack4(v);
    }
  }
  lds_barrier();
}
#undef KV_LOAD
#undef KV_STORE

DI void scan_pair16(const Params& p, int L, int nseq, int nch, int chain, int pair, char* lds) {
  TILE_VARS
  const int t5 = opaque_tid();
  const int half = __builtin_amdgcn_readfirstlane(t5 >> 8);
  char* const wsb = opaque_ptr(p.ws);
  char* const own = lds + half * HALF_LDS;
  bf16_t* St = (bf16_t*)own;
  bf16_t* Vnt = (bf16_t*)(own + 8704);
  bf16_t* Vnk = (bf16_t*)(own + 11008);
  bf16_t* Ws = (bf16_t*)(lds + 13312);
  bf16_t* Qs = (bf16_t*)(lds + 30720);
  bf16_t* As = (bf16_t*)(lds + 48128);
  bf16_t* Ks = (bf16_t*)(lds + 57344);
  const bf16_t* QKV = (const bf16_t*)(wsb + O_QKV);
  const bf16_t* WB = (const bf16_t*)(wsb + O_WB);
  const bf16_t* UB = (const bf16_t*)(wsb + O_UB);
  const bf16_t* AI = (const bf16_t*)(wsb + O_AI);
  const float* GC = (const float*)(wsb + O_GC);
  bf16_t* OB = (bf16_t*)(wsb + O_OB);
  const int h = chain & 3;
  const int seqi = (chain >> 2) % nseq, dir = (chain >> 2) / nseq;
  const size_t idx0 = (size_t)chain * nch;
  const int ecol0 = h * 128 + (2 * pair + half) * 16;
  const int r5 = t5 >> 4, c4 = (t5 & 15) * 8;
  const int r6 = t5 >> 3, c3 = (t5 & 7) * 8;

  for (int i = tid; i < 2 * 16 * 136 / 2; i += 256) ((unsigned*)St)[i] = 0u;
  f32x4 accS[2];
  accS[0] = f32x4{0, 0, 0, 0};
  accS[1] = f32x4{0, 0, 0, 0};

  uint4 pw0, pw1, pq0, pq1, pk0, pk1, pa0;
  float pgl, pge;
  float4 pgv;
  bf16_t pu[4];
  auto prefetchA = [&](int np) {
    const size_t idx = idx0 + np;
    const int n = dir ? nch - 1 - np : np;
    const int tb = seqi * L + n * 64;
    pgl = GC[idx * 64 + 63];
    pge = GC[idx * 64 + w * 16 + fr];
    pgv = *(const float4*)(GC + idx * 64 + w * 16 + fq * 4);
    const bf16_t* qb = QKV + h * 128 + c4;
    pq0 = *(const uint4*)(qb + (size_t)(tb + (dir ? 63 - r5 : r5)) * 1536);
    pq1 = *(const uint4*)(qb + (size_t)(tb + (dir ? 31 - r5 : r5 + 32)) * 1536);
    const bf16_t* wb = WB + idx * 8192 + (size_t)r5 * 128 + c4;
    pw0 = *(const uint4*)(wb); pw1 = *(const uint4*)(wb + 32 * 128);
#pragma unroll
    for (int r = 0; r < 4; r++) pu[r] = UB[idx * 8192 + (w * 16 + fq * 4 + r) * 128 + (ecol0 & 127) + fr];
  };
  auto prefetchB = [&](int np) {
    const size_t idx = idx0 + np;
    const int n = dir ? nch - 1 - np : np;
    const int tb = seqi * L + n * 64;
    const bf16_t* kb = QKV + 512 + h * 128 + c4;
    pk0 = *(const uint4*)(kb + (size_t)(tb + (dir ? 63 - r5 : r5)) * 1536);
    pk1 = *(const uint4*)(kb + (size_t)(tb + (dir ? 31 - r5 : r5 + 32)) * 1536);
    pa0 = *(const uint4*)(AI + idx * 4096 + (size_t)r6 * 64 + c3);
  };
  prefetchA(0);
  prefetchB(0);
#pragma unroll 1
  for (int np = 0; np < nch; np++) {
    const int n = dir ? nch - 1 - np : np;
    const int tb = seqi * L + n * 64;
    const float gl = pgl;
    const bf16_t* Sc = St + (np & 1) * (16 * 136);
    bf16_t* Sn = St + ((np + 1) & 1) * (16 * 136);
    *(uint4*)(Ws + r5 * 136 + c4) = pw0;
    *(uint4*)(Ws + (r5 + 32) * 136 + c4) = pw1;
    *(uint4*)(Qs + r5 * 136 + c4) = pq0;
    *(uint4*)(Qs + (r5 + 32) * 136 + c4) = pq1;
    const float eg = __expf(pge);
    const float ek0 = __expf(gl - pgv.x), ek1 = __expf(gl - pgv.y), ek2 = __expf(gl - pgv.z), ek3 = __expf(gl - pgv.w);
    const float ur0 = bf2f(pu[0]), ur1 = bf2f(pu[1]), ur2 = bf2f(pu[2]), ur3 = bf2f(pu[3]);
    if (np + 1 < nch) prefetchA(np + 1);
    lds_barrier();
    f32x4 accV = f32x4{0, 0, 0, 0}, accQ = f32x4{0, 0, 0, 0};
#pragma unroll
    for (int ks = 0; ks < 4; ks++) {
      const bf16x8 aw = *(const bf16x8*)(Ws + (w * 16 + fr) * 136 + ks * 32 + fq * 8);
      const bf16x8 aq = *(const bf16x8*)(Qs + (w * 16 + fr) * 136 + ks * 32 + fq * 8);
      const bf16x8 bb = *(const bf16x8*)(Sc + fr * 136 + ks * 32 + fq * 8);
      accV = MFMA(aw, bb, accV);
      accQ = MFMA(bb, aq, accQ);
    }
    {
      f32x4 vn, vk;
      vn[0] = ur0 - accV[0]; vn[1] = ur1 - accV[1]; vn[2] = ur2 - accV[2]; vn[3] = ur3 - accV[3];
      vk[0] = vn[0] * ek0; vk[1] = vn[1] * ek1; vk[2] = vn[2] * ek2; vk[3] = vn[3] * ek3;
      *(uint2*)(Vnt + fr * 72 + w * 16 + fq * 4) = pack4(vn);
      *(uint2*)(Vnk + fr * 72 + w * 16 + fq * 4) = pack4(vk);
    }
    *(uint4*)(Ks + r5 * 144 + c4) = pk0;
    *(uint4*)(Ks + (r5 + 32) * 144 + c4) = pk1;
    *(uint4*)(As + r6 * 72 + c3) = pa0;
    if (np + 1 < nch) prefetchB(np + 1);
    lds_barrier();
    const float dS = __expf(gl);
#pragma unroll
    for (int r = 0; r < 4; r++) { accS[0][r] *= dS; accS[1][r] *= dS; }
    bf16x8 kfr[2][2];
    {
      const unsigned kb = (unsigned)(size_t)Ks + (unsigned)((fq * 8 + (fr >> 2)) * 288 + (2 * w) * 32 + (fr & 3) * 8);
      s16x4 t0, t1, t2, t3, t4, t5v, t6, t7;
      TR8(kb, 0, 1152, 32, 1184, 9216, 10368, 9248, 10400, t0, t1, t2, t3, t4, t5v, t6, t7);
      kfr[0][0] = cat8(t0, t1); kfr[0][1] = cat8(t2, t3); kfr[1][0] = cat8(t4, t5v); kfr[1][1] = cat8(t6, t7);
    }
    f32x4 accO = f32x4{0, 0, 0, 0};
#pragma unroll
    for (int ks = 0; ks < 2; ks++) {
      const bf16x8 aa = *(const bf16x8*)(As + (w * 16 + fr) * 72 + ks * 32 + fq * 8);
      const bf16x8 bn = *(const bf16x8*)(Vnt + fr * 72 + ks * 32 + fq * 8);
      const bf16x8 bk = *(const bf16x8*)(Vnk + fr * 72 + ks * 32 + fq * 8);
      accO = MFMA(bn, aa, accO);
      accS[0] = MFMA(kfr[ks][0], bk, accS[0]);
      accS[1] = MFMA(kfr[ks][1], bk, accS[1]);
    }
    {
      const int c = w * 16 + fr;
      const int tl = tb + (dir ? 63 - c : c);
      f32x4 o;
#pragma unroll
      for (int r = 0; r < 4; r++) o[r] = eg * accQ[r] + accO[r];
      *(uint2*)(OB + ((size_t)dir * TS + tl) * 512 + ecol0 + fq * 4) = pack4(o);
    }
    *(uint2*)(Sn + fr * 136 + (2 * w) * 16 + fq * 4) = pack4(accS[0]);
    *(uint2*)(Sn + fr * 136 + (2 * w + 1) * 16 + fq * 4) = pack4(accS[1]);
  }
  lds_barrier();
}

template <int NS>
DI void scan_item(const Params& p, int L, int nseq, int nch, int item, char* smem) {
  TILE_VARS
  char* const wsb = opaque_ptr(p.ws);
  bf16_t* St = (bf16_t*)smem;
  bf16_t* Vnt = (bf16_t*)(smem + 8704);
  bf16_t* Ws = (bf16_t*)(smem + 13312);
  bf16_t* Qgs = (bf16_t*)(smem + 30720);
  bf16_t* As = (bf16_t*)(smem + 48128);
  bf16_t* Kg = (bf16_t*)(smem + 57344);
  const bf16_t* QKV = (const bf16_t*)(wsb + O_QKV);
  const bf16_t* WB = (const bf16_t*)(wsb + O_WB);
  const bf16_t* UB = (const bf16_t*)(wsb + O_UB);
  const bf16_t* AI = (const bf16_t*)(wsb + O_AI);
  const float* GC = (const float*)(wsb + O_GC);
  bf16_t* OB = (bf16_t*)(wsb + O_OB);
  constexpr int NSL = 8 / NS;
  const int slice = item % NSL;
  int tmp = item / NSL;
  const int h = tmp & 3;
  tmp >>= 2;
  const int seqi = tmp % nseq, dir = tmp / nseq;
  const size_t idx0 = (size_t)((dir * nseq + seqi) * 4 + h) * nch;
  const int ecol0 = h * 128 + slice * NS * 16;

  for (int i = tid; i < 32 * 136 / 2; i += 256) ((unsigned*)St)[i] = 0u;
  f32x4 accS[2][NS];
#pragma unroll
  for (int a = 0; a < 2; a++)
#pragma unroll
    for (int b = 0; b < NS; b++) accS[a][b] = f32x4{0, 0, 0, 0};

  uint4 pw0, pw1, pw2, pw3, pq[4], pk[4], pa0, pa1;
  float pg[4], pgl;
  bf16_t pu[NS][4];
  auto prefetch = [&](int np) {
    const size_t idx = idx0 + np;
    const int n = dir ? nch - 1 - np : np;
    const int tb = seqi * L + n * 64;
    pgl = GC[idx * 64 + 63];
#pragma unroll
    for (int i = 0; i < 4; i++) {
      const int id = tid + i * 256, row = id >> 4, kc = id & 15;
      const int tl = tb + (dir ? 63 - row : row);
      const bf16_t* base = QKV + (size_t)tl * 1536 + h * 128 + kc * 8;
      pq[i] = *(const uint4*)(base);
      pk[i] = *(const uint4*)(base + 512);
      pg[i] = GC[idx * 64 + row];
    }
    pw0 = *(const uint4*)(WB + idx * 8192 + (size_t)(tid >> 4) * 128 + (tid & 15) * 8);
    pw1 = *(const uint4*)(WB + idx * 8192 + (size_t)((tid >> 4) + 16) * 128 + (tid & 15) * 8);
    pw2 = *(const uint4*)(WB + idx * 8192 + (size_t)((tid >> 4) + 32) * 128 + (tid & 15) * 8);
    pw3 = *(const uint4*)(WB + idx * 8192 + (size_t)((tid >> 4) + 48) * 128 + (tid & 15) * 8);
    pa0 = *(const uint4*)(AI + idx * 4096 + (size_t)(tid >> 3) * 64 + (tid & 7) * 8);
    pa1 = *(const uint4*)(AI + idx * 4096 + (size_t)((tid >> 3) + 32) * 64 + (tid & 7) * 8);
#pragma unroll
    for (int j = 0; j < NS; j++)
#pragma unroll
      for (int r = 0; r < 4; r++) pu[j][r] = UB[idx * 8192 + (w * 16 + fq * 4 + r) * 128 + (ecol0 & 127) + j * 16 + fr];
  };
  prefetch(0);
#pragma unroll 1
  for (int np = 0; np < nch; np++) {
    const int n = dir ? nch - 1 - np : np;
    const int tb = seqi * L + n * 64;
    const float gl = pgl;
#pragma unroll
    for (int i = 0; i < 4; i++) {
      const int id = tid + i * 256, row = id >> 4, kc = id & 15;
      const float eg = __expf(pg[i]), ek = __expf(gl - pg[i]);
      const uint4 q = pq[i], k = pk[i];
      uint4 qo;
      qo.x = pack2(lo2f(q.x) * eg, hi2f(q.x) * eg);
      qo.y = pack2(lo2f(q.y) * eg, hi2f(q.y) * eg);
      qo.z = pack2(lo2f(q.z) * eg, hi2f(q.z) * eg);
      qo.w = pack2(lo2f(q.w) * eg, hi2f(q.w) * eg);
      *(uint4*)(Qgs + row * 136 + kc * 8) = qo;
      uint4 ko;
      ko.x = pack2(lo2f(k.x) * ek, hi2f(k.x) * ek);
      ko.y = pack2(lo2f(k.y) * ek, hi2f(k.y) * ek);
      ko.z = pack2(lo2f(k.z) * ek, hi2f(k.z) * ek);
      ko.w = pack2(lo2f(k.w) * ek, hi2f(k.w) * ek);
      *(uint4*)(Kg + row * 144 + kc * 8) = ko;
    }
    *(uint4*)(Ws + (tid >> 4) * 136 + (tid & 15) * 8) = pw0;
    *(uint4*)(Ws + ((tid >> 4) + 16) * 136 + (tid & 15) * 8) = pw1;
    *(uint4*)(Ws + ((tid >> 4) + 32) * 136 + (tid & 15) * 8) = pw2;
    *(uint4*)(Ws + ((tid >> 4) + 48) * 136 + (tid & 15) * 8) = pw3;
    *(uint4*)(As + (tid >> 3) * 72 + (tid & 7) * 8) = pa0;
    *(uint4*)(As + ((tid >> 3) + 32) * 72 + (tid & 7) * 8) = pa1;
    float ureg[NS][4];
#pragma unroll
    for (int j = 0; j < NS; j++)
#pragma unroll
      for (int r = 0; r < 4; r++) ureg[j][r] = bf2f(pu[j][r]);
    if (np + 1 < nch) prefetch(np + 1);
    lds_barrier();
    f32x4 accV[NS], accO[NS];
#pragma unroll
    for (int j = 0; j < NS; j++) { accV[j] = f32x4{0, 0, 0, 0}; accO[j] = f32x4{0, 0, 0, 0}; }
#pragma unroll
    for (int ks = 0; ks < 4; ks++) {
      const bf16x8 aw = *(const bf16x8*)(Ws + (w * 16 + fr) * 136 + ks * 32 + fq * 8);
      const bf16x8 aq = *(const bf16x8*)(Qgs + (w * 16 + fr) * 136 + ks * 32 + fq * 8);
#pragma unroll
      for (int j = 0; j < NS; j++) {
        const bf16x8 b = *(const bf16x8*)(St + (j * 16 + fr) * 136 + ks * 32 + fq * 8);
        accV[j] = MFMA(aw, b, accV[j]);
        accO[j] = MFMA(b, aq, accO[j]);
      }
    }
#pragma unroll
    for (int j = 0; j < NS; j++) {
      f32x4 vn;
#pragma unroll
      for (int r = 0; r < 4; r++) vn[r] = ureg[j][r] - accV[j][r];
      *(uint2*)(Vnt + (j * 16 + fr) * 72 + w * 16 + fq * 4) = pack4(vn);
    }
    lds_barrier();
    const float dS = __expf(gl);
#pragma unroll
    for (int a = 0; a < 2; a++)
#pragma unroll
      for (int b = 0; b < NS; b++)
#pragma unroll
        for (int r = 0; r < 4; r++) accS[a][b][r] *= dS;
    bf16x8 kfr[2][2];
    {
      const unsigned kb = (unsigned)(size_t)Kg + (unsigned)((fq * 8 + (fr >> 2)) * 288 + (2 * w) * 32 + (fr & 3) * 8);
      s16x4 t0, t1, t2, t3, t4, t5, t6, t7;
      TR8(kb, 0, 1152, 32, 1184, 9216, 10368, 9248, 10400, t0, t1, t2, t3, t4, t5, t6, t7);
      kfr[0][0] = cat8(t0, t1); kfr[0][1] = cat8(t2, t3); kfr[1][0] = cat8(t4, t5); kfr[1][1] = cat8(t6, t7);
    }
#pragma unroll
    for (int ks = 0; ks < 2; ks++) {
      const bf16x8 aa = *(const bf16x8*)(As + (w * 16 + fr) * 72 + ks * 32 + fq * 8);
#pragma unroll
      for (int j = 0; j < NS; j++) {
        const bf16x8 b = *(const bf16x8*)(Vnt + (j * 16 + fr) * 72 + ks * 32 + fq * 8);
        accO[j] = MFMA(b, aa, accO[j]);
        accS[0][j] = MFMA(kfr[ks][0], b, accS[0][j]);
        accS[1][j] = MFMA(kfr[ks][1], b, accS[1][j]);
      }
    }
    {
      const int c = w * 16 + fr;
      const int tl = tb + (dir ? 63 - c : c);
#pragma unroll
      for (int j = 0; j < NS; j++)
        *(uint2*)(OB + ((size_t)dir * TS + tl) * 512 + ecol0 + j * 16 + fq * 4) = pack4(accO[j]);
    }
    lds_barrier();
#pragma unroll
    for (int mi = 0; mi < 2; mi++)
#pragma unroll
      for (int j = 0; j < NS; j++)
        *(uint2*)(St + (j * 16 + fr) * 136 + (2 * w + mi) * 16 + fq * 4) = pack4(accS[mi][j]);
  }
  lds_barrier();
}

using pg8::Unit;
#define EPI_FOR8                                    \
  _Pragma("unroll") for (int ai = 0; ai < 2; ++ai)  \
  _Pragma("unroll") for (int m = 0; m < 4; ++m)     \
  _Pragma("unroll") for (int bj = 0; bj < 2; ++bj)
#define EPI_COL8 (u.pn * 256 + bj * 128 + wc * 32 + fq * 8)
DI uint4 pack8(const f32x4& a, const f32x4& b) { return make_uint4(pack2(a[0], a[1]), pack2(a[2], a[3]), pack2(b[0], b[1]), pack2(b[2], b[3])); }
DI void unpack8(const uint4& g, float (&f)[8]) {
  f[0] = lo2f(g.x); f[1] = hi2f(g.x); f[2] = lo2f(g.y); f[3] = hi2f(g.y);
  f[4] = lo2f(g.z); f[5] = hi2f(g.z); f[6] = lo2f(g.w); f[7] = hi2f(g.w);
}
struct EpiKV {
  static constexpr bool PERM = true;
  bf16_t* KB; bf16_t* VT;
  DI void operator()(const Acc8& acc, const Unit& u, int wr, int wc, int fr, int fq) const {
    EPI_FOR8 {
      const int row = EPI_ROW, col = EPI_COL8;
      const int b = row >> 8, mm = row & 255;
      const f32x4 v0 = acc[ai][bj][m][0], v1 = acc[ai][bj][m][1];
      if (col < 1024) {
        const int hh = col >> 8, d = col & 255;
        *(uint4*)(KB + ((size_t)(b * 4 + hh) * 256 + mm) * 256 + d) = pack8(v0, v1);
      } else {
        const int c2 = col - 1024, hh = c2 >> 8, d = c2 & 255;
#pragma unroll
        for (int r = 0; r < 4; r++) {
          VT[((size_t)(b * 4 + hh) * 256 + d + r) * 256 + mm] = f2bf(v0[r]);
          VT[((size_t)(b * 4 + hh) * 256 + d + 4 + r) * 256 + mm] = f2bf(v1[r]);
        }
      }
    }
  }
};
struct EpiProj {
  static constexpr bool PERM = true;
  bf16_t* PROJ; float* AB;
  DI void operator()(const Acc8& acc, const Unit& u, int wr, int wc, int fr, int fq) const {
    if (u.pn == 20) {
      if (wc == 0 && fq < 2) {
#pragma unroll
        for (int ai = 0; ai < 2; ++ai)
#pragma unroll
          for (int m = 0; m < 4; ++m) {
            const int row = u.pm * 256 + ai * 128 + wr * 64 + m * 16 + fr;
            const f32x4 v0 = acc[ai][0][m][0], v1 = acc[ai][0][m][1];
            *(float4*)(AB + (size_t)row * 16 + fq * 8) = make_float4(v0[0], v0[1], v0[2], v0[3]);
            *(float4*)(AB + (size_t)row * 16 + fq * 8 + 4) = make_float4(v1[0], v1[1], v1[2], v1[3]);
          }
      }
      return;
    }
    const int mode = u.pn >= 12 ? 3 : 0;
    EPI_FOR8 {
      const int row = EPI_ROW, col = EPI_COL8;
      f32x4 v0 = acc[ai][bj][m][0], v1 = acc[ai][bj][m][1];
      if (mode == 3) {
#pragma unroll
        for (int r = 0; r < 4; r++) { v0[r] = sigmoidf_(v0[r]); v1[r] = sigmoidf_(v1[r]); }
      } else if (mode == 2) {
#pragma unroll
        for (int r = 0; r < 4; r++) { v0[r] = geluf_(v0[r]); v1[r] = geluf_(v1[r]); }
      } else if (mode == 1) {
#pragma unroll
        for (int r = 0; r < 4; r++) { v0[r] = siluf_(v0[r]); v1[r] = siluf_(v1[r]); }
      }
      *(uint4*)(PROJ + (size_t)row * 5120 + col) = pack8(v0, v1);
    }
  }
};
template <int PASS>
struct EpiMerge {
  static constexpr bool PERM = true;
  const bf16_t* PROJ; bf16_t* MERGED;
  DI void operator()(const Acc8& acc, const Unit& u, int wr, int wc, int fr, int fq) const {
#pragma unroll
    for (int ai = 0; ai < 2; ++ai) {
      uint4 gr[4][2], mr[4][2];
#pragma unroll
      for (int m = 0; m < 4; ++m)
#pragma unroll
        for (int bj = 0; bj < 2; ++bj) {
          gr[m][bj] = *(const uint4*)(PROJ + (size_t)EPI_ROW * 5120 + (PASS ? 4096 : 3072) + EPI_COL8);
          if (PASS) mr[m][bj] = *(const uint4*)(MERGED + (size_t)EPI_ROW * 1024 + EPI_COL8);
        }
      asm volatile("" ::: "memory");
#pragma unroll
      for (int m = 0; m < 4; ++m)
#pragma unroll
        for (int bj = 0; bj < 2; ++bj) {
          float g[8];
          unpack8(gr[m][bj], g);
          f32x4 v0 = acc[ai][bj][m][0], v1 = acc[ai][bj][m][1];
#pragma unroll
          for (int r = 0; r < 4; r++) { v0[r] *= g[r]; v1[r] *= g[4 + r]; }
          if (PASS) {
            float mo[8];
            unpack8(mr[m][bj], mo);
#pragma unroll
            for (int r = 0; r < 4; r++) { v0[r] += mo[r]; v1[r] += mo[4 + r]; }
          }
          *(uint4*)(MERGED + (size_t)EPI_ROW * 1024 + EPI_COL8) = pack8(v0, v1);
        }
    }
  }
};
struct EpiWout {
  static constexpr bool PERM = false;
  const float* xin; float* out;
  DI void operator()(const Acc8& acc, const Unit& u, int wr, int wc, int fr, int fq) const {
#pragma unroll
    for (int ai = 0; ai < 2; ++ai) {
      float4 xi[4][2][2];
#pragma unroll
      for (int m = 0; m < 4; ++m)
#pragma unroll
        for (int bj = 0; bj < 2; ++bj)
#pragma unroll
          for (int n = 0; n < 2; ++n) xi[m][bj][n] = *(const float4*)(xin + (size_t)EPI_ROW * 1024 + EPI_COL);
      asm volatile("" ::: "memory");
#pragma unroll
      for (int m = 0; m < 4; ++m)
#pragma unroll
        for (int bj = 0; bj < 2; ++bj)
#pragma unroll
          for (int n = 0; n < 2; ++n) {
            const f32x4 v = acc[ai][bj][m][n];
            const float4 x = xi[m][bj][n];
            *(float4*)(out + (size_t)EPI_ROW * 1024 + EPI_COL) = make_float4(x.x + v[0], x.y + v[1], x.z + v[2], x.w + v[3]);
          }
    }
  }
};
struct EpiQ {
  static constexpr bool PERM = true;
  bf16_t* QX;
  DI void operator()(const Acc8& acc, const Unit& u, int wr, int wc, int fr, int fq) const {
    EPI_FOR8 {
      f32x4 v0 = acc[ai][bj][m][0], v1 = acc[ai][bj][m][1];
#pragma unroll
      for (int r = 0; r < 4; r++) { v0[r] *= 0.0625f; v1[r] *= 0.0625f; }
      *(uint4*)(QX + (size_t)EPI_ROW * 1024 + EPI_COL8) = pack8(v0, v1);
    }
  }
};
struct EpiGateUp {
  static constexpr bool PERM = true;
  bf16_t* ACT;
  DI void operator()(const Acc8& acc, const Unit& u, int wr, int wc, int fr, int fq) const {
#pragma unroll
    for (int ai = 0; ai < 2; ++ai)
#pragma unroll
      for (int m = 0; m < 4; ++m) {
        const int row = u.pm * 256 + ai * 128 + wr * 64 + m * 16 + fr;
        const int col = u.pn * 128 + wc * 32 + fq * 8;
        f32x4 v0, v1;
#pragma unroll
        for (int r = 0; r < 4; r++) {
          v0[r] = siluf_(acc[ai][0][m][0][r]) * acc[ai][1][m][0][r];
          v1[r] = siluf_(acc[ai][0][m][1][r]) * acc[ai][1][m][1][r];
        }
        *(uint4*)(ACT + (size_t)row * 2816 + col) = pack8(v0, v1);
      }
  }
};

#define GW_VARS const int gw = VB() * 4 + w, nw = VGRID() * 4;

DI void phase_prologue(const Params& p, char* smem) {
  char* ws = opaque_ptr(p.ws);
  transpose_weight(p.w_in, 1024, 5136, (bf16_t*)(ws + O_WIN), 5376, 1, smem);
  transpose_weight(p.xa_w_kv, 1024, 2048, (bf16_t*)(ws + O_WKV), 2048, 0, smem);
  TILE_VARS
  GW_VARS
  bf16_t* SGW = (bf16_t*)(ws + O_SGW);
  for (int i = VB() * 256 + tid; i < 65536; i += VGRID() * 256) SGW[i] = f2bf(p.sg_w[i]);
  bf16_t* HB = (bf16_t*)(ws + O_HB);
  for (int t = gw * 4; t < TS; t += nw * 4)
    rownorm4_bf16([&](int tt) { return xrow(p, tt); }, t, p.norm_mix_w, HB + (size_t)t * 1024, lane);
  bf16_t* MEMN = (bf16_t*)(ws + O_MEMN);
  for (int t = gw * 4; t < 6144; t += nw * 4)
    rownorm4_bf16([&](int tt) { return tt < 2048 ? p.mem_prompt + (size_t)tt * 1024 : p.mem_sample + (size_t)(tt - 2048) * 1024; }, t,
                  p.norm_mem_w, MEMN + (size_t)t * 1024, lane);
}

DI void phase_conv(const Params& p, int L) {
  TILE_VARS
  GW_VARS
  char* ws = opaque_ptr(p.ws);
  const bf16_t* PROJ = (const bf16_t*)(ws + O_PROJ);
  bf16_t* QKV = (bf16_t*)(ws + O_QKV);
  float* LNST = (float*)(ws + O_LNST);
  const int nItems = 3 * (TS / 16);
  for (int item = gw; item < nItems; item += nw) {
    const int g = item % 3, run = item / 3;
    const int t0 = run * 16;
    const int seqb = (t0 / L) * L, l0 = t0 - seqb;
    const int ch = g * 512 + lane * 8;
    float cw[5][8];
#pragma unroll
    for (int j = 0; j < 5; j++) {
      const float4 a = *(const float4*)(p.conv_w + j * 1536 + ch);
      const float4 b = *(const float4*)(p.conv_w + j * 1536 + ch + 4);
      cw[j][0] = a.x; cw[j][1] = a.y; cw[j][2] = a.z; cw[j][3] = a.w;
      cw[j][4] = b.x; cw[j][5] = b.y; cw[j][6] = b.z; cw[j][7] = b.w;
    }
    uint4 raw[20];
#pragma unroll
    for (int j = 0; j < 20; j++) {
      const int l = l0 - 2 + j;
      raw[j] = (l >= 0 && l < L) ? ld_stream16(PROJ + (size_t)(seqb + l) * 5120 + ch) : make_uint4(0u, 0u, 0u, 0u);
    }
#pragma unroll
    for (int tt = 0; tt < 16; tt++) {
      float o[8];
#pragma unroll
      for (int e = 0; e < 8; e++) o[e] = 0.f;
#pragma unroll
      for (int j = 0; j < 5; j++) {
        const uint4 v = raw[tt + j];
        o[0] += cw[j][0] * lo2f(v.x); o[1] += cw[j][1] * hi2f(v.x); o[2] += cw[j][2] * lo2f(v.y); o[3] += cw[j][3] * hi2f(v.y);
        o[4] += cw[j][4] * lo2f(v.z); o[5] += cw[j][5] * hi2f(v.z); o[6] += cw[j][6] * lo2f(v.w); o[7] += cw[j][7] * hi2f(v.w);
      }
      float ss = 0.f;
#pragma unroll
      for (int e = 0; e < 8; e++) {
        o[e] = siluf_(o[e]);
        ss += o[e] * o[e];
      }
      if (g < 2) {
        ss = sum16(ss);
        const float sc = rsqrtf(ss + 1e-6f) * (g == 0 ? 0.08838834764831845f : 1.f);
#pragma unroll
        for (int e = 0; e < 8; e++) o[e] *= sc;
      }
      uint4 pk;
      pk.x = pack2(o[0], o[1]); pk.y = pack2(o[2], o[3]); pk.z = pack2(o[4], o[5]); pk.w = pack2(o[6], o[7]);
      *(uint4*)(QKV + (size_t)(t0 + tt) * 1536 + ch) = pk;
    }
  }
  for (int t = gw * 4; t < TS; t += nw * 4) {
    uint4 vv[4];
#pragma unroll
    for (int r = 0; r < 4; r++) vv[r] = ld_stream16(PROJ + (size_t)(t + r) * 5120 + 2560 + lane * 8);
#pragma unroll
    for (int r = 0; r < 4; r++) {
      const uint4 v = vv[r];
      float f[8] = {geluf_(lo2f(v.x)), geluf_(hi2f(v.x)), geluf_(lo2f(v.y)), geluf_(hi2f(v.y)),
                    geluf_(lo2f(v.z)), geluf_(hi2f(v.z)), geluf_(lo2f(v.w)), geluf_(hi2f(v.w))};
      float sm = 0.f;
#pragma unroll
      for (int e = 0; e < 8; e++) sm += f[e];
      const float mu = wave_sum(sm) * (1.f / 512.f);
      float q = 0.f;
#pragma unroll
      for (int e = 0; e < 8; e++) q += (f[e] - mu) * (f[e] - mu);
      const float var = wave_sum(q) * (1.f / 512.f);
      if (lane == 0) {
        LNST[(size_t)(t + r) * 2] = mu;
        LNST[(size_t)(t + r) * 2 + 1] = rsqrtf(var + 1e-6f);
      }
    }
  }
}

DI void phase_dnout(const Params& p) {
  TILE_VARS
  GW_VARS
  char* ws = opaque_ptr(p.ws);
  const bf16_t* PROJ = (const bf16_t*)(ws + O_PROJ);
  const bf16_t* OB = (const bf16_t*)(ws + O_OB);
  bf16_t* DNO = (bf16_t*)(ws + O_DNO);
  const float4 nw0 = *(const float4*)(p.dn_norm_w + (lane & 15) * 8);
  const float4 nw1 = *(const float4*)(p.dn_norm_w + (lane & 15) * 8 + 4);
  const float nwv[8] = {nw0.x, nw0.y, nw0.z, nw0.w, nw1.x, nw1.y, nw1.z, nw1.w};
  for (int t4 = gw * 4; t4 < TS; t4 += nw * 4) {
    uint4 av[4], bv[4], gv[4];
#pragma unroll
    for (int r = 0; r < 4; r++) {
      av[r] = ld_stream16(OB + (size_t)(t4 + r) * 512 + lane * 8);
      bv[r] = ld_stream16(OB + ((size_t)TS + t4 + r) * 512 + lane * 8);
      gv[r] = ld_stream16(PROJ + (size_t)(t4 + r) * 5120 + 1536 + lane * 8);
    }
#pragma unroll
    for (int r = 0; r < 4; r++) {
      const uint4 a = av[r], b = bv[r], gt = gv[r];
      float o[8] = {lo2f(a.x) + lo2f(b.x), hi2f(a.x) + hi2f(b.x), lo2f(a.y) + lo2f(b.y), hi2f(a.y) + hi2f(b.y),
                    lo2f(a.z) + lo2f(b.z), hi2f(a.z) + hi2f(b.z), lo2f(a.w) + lo2f(b.w), hi2f(a.w) + hi2f(b.w)};
      const float gg[8] = {siluf_(lo2f(gt.x)), siluf_(hi2f(gt.x)), siluf_(lo2f(gt.y)), siluf_(hi2f(gt.y)),
                           siluf_(lo2f(gt.z)), siluf_(hi2f(gt.z)), siluf_(lo2f(gt.w)), siluf_(hi2f(gt.w))};
      float ss = 0.f;
#pragma unroll
      for (int e = 0; e < 8; e++) ss += o[e] * o[e];
      ss = sum16(ss);
      const float rs = rsqrtf(ss * (1.f / 128.f) + 1e-6f);
#pragma unroll
      for (int e = 0; e < 8; e++) o[e] = o[e] * rs * nwv[e] * gg[e];
      uint4 pk;
      pk.x = pack2(o[0], o[1]); pk.y = pack2(o[2], o[3]); pk.z = pack2(o[4], o[5]); pk.w = pack2(o[6], o[7]);
      *(uint4*)(DNO + (size_t)(t4 + r) * 512 + lane * 8) = pk;
    }
  }
}

DI void phase_norm_out(const Params& p, const float* wgt) {
  TILE_VARS
  GW_VARS
  bf16_t* HB = (bf16_t*)(opaque_ptr(p.ws) + O_HB);
  const float* outp = p.out;
  for (int t = gw * 4; t < NTOK; t += nw * 4)
    rownorm4_bf16([&](int tt) { return outp + (size_t)tt * 1024; }, t, wgt, HB + (size_t)t * 1024, lane);
}

DI void phase_final(const Params& p) {
  TILE_VARS
  GW_VARS
  float4 ww[4];
#pragma unroll
  for (int i = 0; i < 4; i++) ww[i] = ((const float4*)p.final_norm_w)[lane + i * 64];
  for (int t = gw * 4; t < NTOK; t += nw * 4) {
    float* rowp = p.out + (size_t)t * 1024;
    float4 v[4][4];
#pragma unroll
    for (int r = 0; r < 4; r++)
#pragma unroll
      for (int i = 0; i < 4; i++) v[r][i] = ld_stream(rowp + r * 1024 + (lane + i * 64) * 4);
#pragma unroll
    for (int r = 0; r < 4; r++) {
      float ss = 0.f;
#pragma unroll
      for (int i = 0; i < 4; i++) ss += v[r][i].x * v[r][i].x + v[r][i].y * v[r][i].y + v[r][i].z * v[r][i].z + v[r][i].w * v[r][i].w;
      ss = wave_sum(ss);
      const float rs = rsqrtf(ss * (1.f / 1024.f) + 1e-6f);
#pragma unroll
      for (int i = 0; i < 4; i++)
        ((float4*)(rowp + r * 1024))[lane + i * 64] =
            make_float4(v[r][i].x * rs * ww[i].x, v[r][i].y * rs * ww[i].y, v[r][i].z * rs * ww[i].z, v[r][i].w * rs * ww[i].w);
    }
  }
}

__global__ void __launch_bounds__(512, 2) fwd_megakernel(Params p) {
  extern __shared__ __attribute__((aligned(16))) char dyn_smem[];
  cg::grid_group grid = cg::this_grid();
  LAS unsigned char* glds = (LAS unsigned char*)dyn_smem;
  char* smem = dyn_smem + __builtin_amdgcn_readfirstlane(threadIdx.x >> 8) * HALF_LDS;
  char* ws = opaque_ptr(p.ws);
  const bf16_t* HB = (const bf16_t*)(ws + O_HB);
  volatile LAS unsigned* xst = (volatile LAS unsigned*)(glds + LDS_BYTES);
  if (threadIdx.x == 0) { xst[0] = 0u; xst[1] = 0u; }
  __syncthreads();
  const XcdBarrier xb = xcd_barrier_post((unsigned*)(ws + O_BAR), xst);

  phase_prologue(p, smem);
  grid.sync();
#pragma unroll 1
  for (int slab = 0; slab < 3; slab++) {
    const int tok0 = slab * TS;
    const int L = slab < 2 ? 8192 : 2048;
    const int nseq = slab < 2 ? 4 : 16;
    const int nch = L / 64;
    {
      EpiProj E{(bf16_t*)(ws + O_PROJ), (float*)(ws + O_AB)};
      pg8::gemm_phase(glds, pg8::Gemm{HB + (size_t)tok0 * 1024, (const bf16_t*)(ws + O_WIN), TS, 5376, 1024, 1024, 1024}, E);
    }
    xcd_barrier(xb);
    phase_conv(p, L);
    xcd_barrier(xb);
    {
      const int nPrep = 2 * nseq * 4 * nch;
#pragma unroll 1
      for (int item = VB(); item < nPrep; item += VGRID()) prep_item(p, L, nseq, nch, item, smem);
      if (slab == 2) {
#pragma unroll 1
        for (int item = VB(); item < 1024; item += VGRID()) sgmix_item(p, item, smem);
      }
    }
    xcd_barrier(xb);
    if (slab < 2) {
      const int nScan = 2 * nseq * 4 * 8;
      if (VB() < nScan) {
        const int bx = blockIdx.x, xcd = bx & 7, j = bx >> 3;
        const int chain = (j >> 2) * 8 + xcd;
        scan_pair16(p, L, nseq, nch, chain, j & 3, dyn_smem);
      } else {
#pragma unroll 1
        for (int item = VB() - nScan; item < 1024; item += VGRID() - nScan) sgmix_item(p, item, smem);
        {
          const int vb_ = VB() - nScan, vg_ = VGRID() - nScan;
          const int tid_ = opaque_tid() & 255, lane_ = tid_ & 63, w_ = tid_ >> 6;
          const int gw_ = vb_ * 4 + w_, nw_ = vg_ * 4;
          bf16_t* HBw = (bf16_t*)(ws + O_HB);
          if (slab == 0) {
            transpose_weight(p.w_up_a, 512, 1024, (bf16_t*)(ws + O_WUPA), 1024, 0, smem, vb_, vg_);
            transpose_weight(p.w_up_b, 512, 1024, (bf16_t*)(ws + O_WUPB), 1024, 0, smem, vb_, vg_);
            transpose_weight(p.w_out, 1024, 1024, (bf16_t*)(ws + O_WOUT), 1024, 0, smem, vb_, vg_);
            const int nIdle = (int)gridDim.x - nScan / 2;
            EpiKV E{(bf16_t*)(ws + O_KB), (bf16_t*)(ws + O_VT)};
            pg8::gemm_phase(glds, pg8::Gemm{(const bf16_t*)(ws + O_MEMN), (const bf16_t*)(ws + O_WKV), 6144, 2048, 1024, 1024, 1024}, E, nIdle,
                            (int)blockIdx.x - nScan / 2);
            for (int t = TS + gw_ * 4; t < 2 * TS; t += nw_ * 4)
              rownorm4_bf16([&](int tt) { return xrow(p, tt); }, t, p.norm_mix_w, HBw + (size_t)t * 1024, lane_);
          } else {
            transpose_weight(p.xa_w_q, 1024, 1024, (bf16_t*)(ws + O_WQ), 1024, 0, smem, vb_, vg_);
            transpose_weight(p.xa_w_o, 1024, 1024, (bf16_t*)(ws + O_WO), 1024, 0, smem, vb_, vg_);
            transpose_weight(p.ffn_w_gu, 1024, 5632, (bf16_t*)(ws + O_WGU), 5632, 2, smem, vb_, vg_);
            transpose_weight(p.ffn_w_down, 2816, 1024, (bf16_t*)(ws + O_WDN), 1024, 0, smem, vb_, vg_);
            for (int t = 2 * TS + gw_ * 4; t < NTOK; t += nw_ * 4)
              rownorm4_bf16([&](int tt) { return xrow(p, tt); }, t, p.norm_mix_w, HBw + (size_t)t * 1024, lane_);
          }
        }
      }
    } else {
      const int bx = blockIdx.x, xcd = bx & 7, j = bx >> 3;
      const int chain = (j >> 1) * 8 + xcd, slice = 2 * (j & 1) + __builtin_amdgcn_readfirstlane(threadIdx.x >> 8);
      scan_item<2>(p, L, nseq, nch, chain * 4 + slice, smem);
    }
    xcd_barrier(xb);
    phase_dnout(p);
    xcd_barrier(xb);
    {
      EpiMerge<0> E0{(const bf16_t*)(ws + O_PROJ), (bf16_t*)(ws + O_MERGED)};
      pg8::gemm_phase(glds, pg8::Gemm{(const bf16_t*)(ws + O_DNO), (const bf16_t*)(ws + O_WUPA), TS, 1024, 512, 512, 512}, E0);
      EpiMerge<1> E1{(const bf16_t*)(ws + O_PROJ), (bf16_t*)(ws + O_MERGED)};
      pg8::gemm_phase(glds, pg8::Gemm{(const bf16_t*)(ws + O_PROJ) + 2048, (const bf16_t*)(ws + O_WUPB), TS, 1024, 512, 5120, 512}, E1);
    }
    xcd_barrier(xb);
    {
      EpiWout E{slab < 2 ? p.x_prompt + (size_t)tok0 * 1024 : p.x_sample, p.out + (size_t)tok0 * 1024};
      pg8::gemm_phase(glds, pg8::Gemm{(const bf16_t*)(ws + O_MERGED), (const bf16_t*)(ws + O_WOUT), TS, 1024, 1024, 1024, 1024}, E);
    }
    xcd_barrier(xb);
  }

  phase_norm_out(p, p.norm_xa_w);
  xcd_barrier(xb);
  {
    EpiQ E{(bf16_t*)(ws + O_QX)};
    pg8::gemm_phase(glds, pg8::Gemm{HB, (const bf16_t*)(ws + O_WQ), NTOK, 1024, 1024, 1024, 1024}, E);
  }
  xcd_barrier(xb);
#pragma unroll 1
  for (int item = VB(); item < (NTOK / 64) * 4; item += VGRID()) attn_item(p, item, smem);
  xcd_barrier(xb);
  {
    EpiWout E{p.out, p.out};
    pg8::gemm_phase(glds, pg8::Gemm{(const bf16_t*)(ws + O_ATT), (const bf16_t*)(ws + O_WO), NTOK, 1024, 1024, 1024, 1024}, E);
  }
  xcd_barrier(xb);
  phase_norm_out(p, p.norm_ffn_w);
  xcd_barrier(xb);
  {
    EpiGateUp E{(bf16_t*)(ws + O_ACT)};
    pg8::gemm_phase(glds, pg8::Gemm{HB, (const bf16_t*)(ws + O_WGU), NTOK, 5632, 1024, 1024, 1024}, E);
  }
  xcd_barrier(xb);
  {
    EpiWout E{p.out, p.out};
    pg8::gemm_phase(glds, pg8::Gemm{(const bf16_t*)(ws + O_ACT), (const bf16_t*)(ws + O_WDN), NTOK, 1024, 2816, 2816, 2816}, E);
  }
  xcd_barrier(xb);
  phase_final(p);
}

extern "C" void kernel_launch(void* const* d_in, const int* in_sizes, int n_in, void* d_out, int out_size, void* d_ws,
                              size_t ws_size, hipStream_t stream) {
  static int grid_blocks = 0;
  if (!grid_blocks) {
    (void)hipFuncSetAttribute((const void*)fwd_megakernel, hipFuncAttributeMaxDynamicSharedMemorySize, LDS_BYTES + 16);
    int per_cu = 0;
    (void)hipOccupancyMaxActiveBlocksPerMultiprocessor(&per_cu, fwd_megakernel, 512, LDS_BYTES + 16);
    grid_blocks = 256;
    if (per_cu < 1) fprintf(stderr, "occupancy query returned %d\n", per_cu);
  }
  Params p{};
  const float** pp = (const float**)&p;
  for (int i = 0; i < 26; i++) pp[i] = (const float*)d_in[i];
  p.out = (float*)d_out;
  p.ws = (char*)d_ws;
  void* args[] = {&p};
  (void)hipMemsetAsync(d_ws, 0, XCD_BAR_WORDS * 4, stream);
  hipError_t e = hipLaunchCooperativeKernel((void*)fwd_megakernel, dim3(grid_blocks), dim3(512), args, LDS_BYTES + 16, stream);
  if (e != hipSuccess) fprintf(stderr, "cooperative launch failed: %s (grid %d)\n", hipGetErrorString(e), grid_blocks);
}
```
